# Optimizing an MI355X kernel written in HIP

```python
import math
import jax, jax.numpy as jnp
from jax import lax
import numpy as np

D_MODEL = 1024
BATCH = 4
SEQ = 8192
DEPTH = 4

N_MIXERS = 4
D_FF = 2816
NORM_EPS = 1e-6
N_SUBLAYERS = 3
N_ADA = 3 * N_SUBLAYERS
POOL_WINDOWS = (2, 4, 8, 16)
POOL_GROUP = D_MODEL // len(POOL_WINDOWS)
POOL_MAX_W = max(POOL_WINDOWS)
FOX_HEADS = 16
FOX_HEAD_DIM = D_MODEL // FOX_HEADS
FOX_BLOCK = 128
S5_GROUP = 16
S5_GROUPS = D_MODEL // S5_GROUP
S5_STATE = 64
S5_DT_MIN = 1e-3
S5_DT_MAX = 1e-1
CONV_WIDTH = 3
LAYERS_PER_MIXER = tuple(len(range(m, DEPTH, N_MIXERS)) for m in range(N_MIXERS))

kernel_name = "hybrid_pool_fox_s5_conv_macaron"


def rms_norm(x, gain):
    xf = x.astype(jnp.float32)
    y = xf * lax.rsqrt(jnp.mean(xf * xf, axis=-1, keepdims=True) + NORM_EPS)
    return (y * gain.astype(jnp.float32)).astype(x.dtype)


def adaln(x, gain, shift, scale):
    return rms_norm(x, gain) * (1.0 + scale[:, None, :]) + shift[:, None, :]


def swiglu(h, w_in, w_out):
    g, u = jnp.split(h @ w_in, 2, axis=-1)
    return (jax.nn.silu(g) * u) @ w_out


def pool_mixer(h, w_grp, scale):
    b_, s_, d_ = h.shape
    hf = h.astype(jnp.float32)
    cs = jnp.cumsum(hf, axis=1)
    cs_pad = jnp.pad(cs, ((0, 0), (POOL_MAX_W, 0), (0, 0)))
    pos = jnp.arange(s_)
    outs = []
    for gi, w in enumerate(POOL_WINDOWS):
        sl = slice(gi * POOL_GROUP, (gi + 1) * POOL_GROUP)
        prev = cs_pad[:, POOL_MAX_W - w:POOL_MAX_W - w + s_, sl]
        cnt = jnp.minimum(pos + 1, w).astype(jnp.float32)[None, :, None]
        outs.append((cs[..., sl] - prev) / cnt - hf[..., sl])
    pooled = jnp.stack(outs, axis=2)
    mixed = jnp.einsum('bsgc,gcd->bsgd', pooled, w_grp.astype(jnp.float32))
    return (mixed.reshape(b_, s_, d_) * scale.astype(jnp.float32)).astype(h.dtype)


def fox_attention(h, w_in, b_f, q_gain, k_gain, w_o):
    b_, s_, d_ = h.shape
    proj = h @ w_in
    q, k, v, f_logit = jnp.split(proj, [d_, 2 * d_, 3 * d_], axis=-1)
    q = rms_norm(q.reshape(b_, s_, FOX_HEADS, FOX_HEAD_DIM), q_gain) * (FOX_HEAD_DIM ** -0.5)
    k = rms_norm(k.reshape(b_, s_, FOX_HEADS, FOX_HEAD_DIM), k_gain)
    v = v.reshape(b_, s_, FOX_HEADS, FOX_HEAD_DIM)
    q, k, v = (t.transpose(0, 2, 1, 3) for t in (q, k, v))
    log_f = jax.nn.log_sigmoid((f_logit + b_f).astype(jnp.float32))
    cum_f = jnp.cumsum(log_f, axis=1).transpose(0, 2, 1)
    q_idx = jnp.arange(FOX_BLOCK)
    outs = []
    for blk in range(s_ // FOX_BLOCK):
        q0 = blk * FOX_BLOCK
        kv_end = q0 + FOX_BLOCK
        s = jnp.einsum('bhqd,bhkd->bhqk', q[:, :, q0:kv_end], k[:, :, :kv_end]).astype(jnp.float32)
        s = s + cum_f[:, :, q0:kv_end, None] - cum_f[:, :, None, :kv_end]
        mask = (q0 + q_idx)[:, None] >= jnp.arange(kv_end)[None, :]
        p = jax.nn.softmax(jnp.where(mask, s, -jnp.inf), axis=-1)
        outs.append(jnp.einsum('bhqk,bhkd->bhqd', p.astype(v.dtype), v[:, :, :kv_end]))
    o = jnp.concatenate(outs, axis=2).transpose(0, 2, 1, 3).reshape(b_, s_, d_)
    return o @ w_o


def s5_mixer(h, lam_re, lam_im, log_dt, b_re, b_im, c_re, c_im, d_skip, w_glu):
    f32 = jnp.float32
    b_, s_, d_ = h.shape
    u = h.astype(f32).reshape(b_, s_, S5_GROUPS, S5_GROUP)
    dt = jnp.exp(log_dt.astype(f32))[:, None]
    ar, ai = lam_re.astype(f32), lam_im.astype(f32)
    mag = jnp.exp(ar * dt)
    lb_re, lb_im = mag * jnp.cos(ai * dt), mag * jnp.sin(ai * dt)
    den = ar * ar + ai * ai
    nr, ni = lb_re - 1.0, lb_im
    k_re = (nr * ar + ni * ai) / den
    k_im = (ni * ar - nr * ai) / den
    br, bi = b_re.astype(f32), b_im.astype(f32)
    bb_re = k_re[..., None] * br - k_im[..., None] * bi
    bb_im = k_re[..., None] * bi + k_im[..., None] * br
    x_re = jnp.einsum('bsgi,gni->sbgn', u, bb_re)
    x_im = jnp.einsum('bsgi,gni->sbgn', u, bb_im)
    a_re = jnp.broadcast_to(lb_re, (s_, 1) + lb_re.shape)
    a_im = jnp.broadcast_to(lb_im, (s_, 1) + lb_im.shape)

    def combine(e1, e2):
        a1r, a1i, b1r, b1i = e1
        a2r, a2i, b2r, b2i = e2
        return (a1r * a2r - a1i * a2i, a1r * a2i + a1i * a2r,
                a2r * b1r - a2i * b1i + b2r, a2r * b1i + a2i * b1r + b2i)

    _, _, st_re, st_im = lax.associative_scan(combine, (a_re, a_im, x_re, x_im), axis=0)
    y = (jnp.einsum('sbgn,gin->bsgi', st_re, c_re.astype(f32))
         - jnp.einsum('sbgn,gin->bsgi', st_im, c_im.astype(f32)))
    y = y + d_skip.astype(f32).reshape(S5_GROUPS, S5_GROUP) * u
    g = jax.nn.gelu(y.reshape(b_, s_, d_).astype(h.dtype))
    return g * jax.nn.sigmoid(g @ w_glu)


def short_conv_mixer(h, w_in, conv_w, w_out):
    b_gate, c_gate, z = jnp.split(h @ w_in, 3, axis=-1)
    conv = lax.conv_general_dilated(c_gate * z, conv_w, window_strides=(1,),
                                    padding=((CONV_WIDTH - 1, 0),),
                                    dimension_numbers=('NWC', 'WIO', 'NWC'),
                                    feature_group_count=D_MODEL)
    return (b_gate * conv) @ w_out


def setup_inputs(seed: int = 0) -> dict:
    key = jax.random.key(seed)
    ks = iter(jax.random.split(key, 32))
    f32 = jnp.float32
    D = D_MODEL
    n_a, n_b, n_c, n_d = LAYERS_PER_MIXER

    def nrm(shape, std):
        return jax.random.normal(next(ks), shape, f32) * std

    x = nrm((BATCH, SEQ, D), 1.0)
    c = nrm((BATCH, D), 1.0)
    ada_w = nrm((DEPTH, D, N_ADA * D), 0.1 * D ** -0.5)
    ada_b = nrm((DEPTH, N_ADA * D), 0.01)
    norm_g = 1.0 + nrm((DEPTH, N_SUBLAYERS, D), 0.01)
    ffn_w_in = nrm((DEPTH, 2, D, 2 * D_FF), D ** -0.5)
    ffn_w_out = nrm((DEPTH, 2, D_FF, D), D_FF ** -0.5)
    pool_w = nrm((n_a, len(POOL_WINDOWS), POOL_GROUP, POOL_GROUP), POOL_GROUP ** -0.5)
    pool_scale = 1.0 + nrm((n_a, D), 0.02)
    fox_w_in = nrm((n_b, D, 3 * D + FOX_HEADS), D ** -0.5)
    fox_b_f = 2.0 + nrm((n_b, FOX_HEADS), 0.5)
    fox_q_gain = 1.0 + nrm((n_b, FOX_HEAD_DIM), 0.01)
    fox_k_gain = 1.0 + nrm((n_b, FOX_HEAD_DIM), 0.01)
    fox_w_o = nrm((n_b, D, D), D ** -0.5)
    n_idx = jnp.arange(S5_STATE, dtype=f32)
    s5_lam_re = -0.5 + nrm((n_c, S5_GROUPS, S5_STATE), 0.01)
    s5_lam_im = math.pi * n_idx + nrm((n_c, S5_GROUPS, S5_STATE), 0.01)
    s5_log_dt = jax.random.uniform(next(ks), (n_c, S5_GROUPS), f32,
                                   math.log(S5_DT_MIN), math.log(S5_DT_MAX))
    s5_b_re = nrm((n_c, S5_GROUPS, S5_STATE, S5_GROUP), (2 * S5_GROUP) ** -0.5)
    s5_b_im = nrm((n_c, S5_GROUPS, S5_STATE, S5_GROUP), (2 * S5_GROUP) ** -0.5)
    s5_c_re = nrm((n_c, S5_GROUPS, S5_GROUP, S5_STATE), 2.0 * S5_STATE ** -0.5)
    s5_c_im = nrm((n_c, S5_GROUPS, S5_GROUP, S5_STATE), 2.0 * S5_STATE ** -0.5)
    s5_d = nrm((n_c, D), 0.5)
    s5_w_glu = nrm((n_c, D, D), D ** -0.5)
    conv_w_in = nrm((n_d, D, 3 * D), D ** -0.5)
    conv_w = nrm((n_d, CONV_WIDTH, 1, D), CONV_WIDTH ** -0.5)
    conv_w_out = nrm((n_d, D, D), D ** -0.5)
    return {"x": x, "c": c, "ada_w": ada_w, "ada_b": ada_b, "norm_g": norm_g,
            "ffn_w_in": ffn_w_in, "ffn_w_out": ffn_w_out,
            "pool_w": pool_w, "pool_scale": pool_scale,
            "fox_w_in": fox_w_in, "fox_b_f": fox_b_f, "fox_q_gain": fox_q_gain,
            "fox_k_gain": fox_k_gain, "fox_w_o": fox_w_o,
            "s5_lam_re": s5_lam_re, "s5_lam_im": s5_lam_im, "s5_log_dt": s5_log_dt,
            "s5_b_re": s5_b_re, "s5_b_im": s5_b_im, "s5_c_re": s5_c_re, "s5_c_im": s5_c_im,
            "s5_d": s5_d, "s5_w_glu": s5_w_glu,
            "conv_w_in": conv_w_in, "conv_w": conv_w, "conv_w_out": conv_w_out}


def reference(x, c, ada_w, ada_b, norm_g, ffn_w_in, ffn_w_out, pool_w, pool_scale,
              fox_w_in, fox_b_f, fox_q_gain, fox_k_gain, fox_w_o,
              s5_lam_re, s5_lam_im, s5_log_dt, s5_b_re, s5_b_im, s5_c_re, s5_c_im,
              s5_d, s5_w_glu, conv_w_in, conv_w, conv_w_out):
    b_ = x.shape[0]
    cond = jax.nn.silu(c)
    for i in range(DEPTH):
        mod = (cond @ ada_w[i] + ada_b[i]).reshape(b_, N_SUBLAYERS, 3, D_MODEL)
        h = adaln(x, norm_g[i, 0], mod[:, 0, 0], mod[:, 0, 1])
        x = x + 0.5 * (1.0 + mod[:, 0, 2][:, None, :]) * swiglu(h, ffn_w_in[i, 0], ffn_w_out[i, 0])
        h = adaln(x, norm_g[i, 1], mod[:, 1, 0], mod[:, 1, 1])
        m, r = i % N_MIXERS, i // N_MIXERS
        if m == 0:
            y = pool_mixer(h, pool_w[r], pool_scale[r])
        elif m == 1:
            y = fox_attention(h, fox_w_in[r], fox_b_f[r], fox_q_gain[r], fox_k_gain[r], fox_w_o[r])
        elif m == 2:
            y = s5_mixer(h, s5_lam_re[r], s5_lam_im[r], s5_log_dt[r], s5_b_re[r], s5_b_im[r],
                         s5_c_re[r], s5_c_im[r], s5_d[r], s5_w_glu[r])
        else:
            y = short_conv_mixer(h, conv_w_in[r], conv_w[r], conv_w_out[r])
        x = x + (1.0 + mod[:, 1, 2][:, None, :]) * y
        h = adaln(x, norm_g[i, 2], mod[:, 2, 0], mod[:, 2, 1])
        x = x + 0.5 * (1.0 + mod[:, 2, 2][:, None, :]) * swiglu(h, ffn_w_in[i, 1], ffn_w_out[i, 1])
    return x
```

```cpp
#include <hip/hip_runtime.h>
#include <hip/hip_cooperative_groups.h>
#include <cstdio>
#include <cstdint>
namespace cg = cooperative_groups;

#ifndef MK_ONE_LAUNCH
#define MK_ONE_LAUNCH 0
#endif

#define LAS __attribute__((address_space(3)))
typedef unsigned short bf16_t;
typedef short bf16x8 __attribute__((ext_vector_type(8)));
typedef float f32x4 __attribute__((ext_vector_type(4)));
typedef float f32x2 __attribute__((ext_vector_type(2)));
typedef float f32x16 __attribute__((ext_vector_type(16)));
typedef unsigned u32x4 __attribute__((ext_vector_type(4)));
typedef unsigned u32x2 __attribute__((ext_vector_type(2)));
typedef __bf16 bf16x2_t __attribute__((ext_vector_type(2)));

constexpr int D = 1024, BATCH = 4, SEQ = 8192, M = BATCH * SEQ, DFF = 2816, NMOD = 9 * D;
constexpr int NFOX = 3328;
constexpr float EPS = 1e-6f;
constexpr float LOG2E = 1.4426950408889634f;
constexpr float QSCALE = 0.125f * LOG2E;
constexpr int NTHREADS = 512, NWAVES = 8;
constexpr int LDS_BYTES = 131072;

constexpr size_t MiB = 1u << 20;
constexpr size_t WS_MOD = 0, WS_LOGF = 1 * MiB, WS_BIASK = 3 * MiB, WS_E = 5 * MiB;
constexpr size_t WS_WFFIN = 16 * MiB, WS_WFFOUT = 104 * MiB, WS_WFOXIN = 148 * MiB, WS_WFOXO = 155 * MiB, WS_WGLU = 157 * MiB,
                 WS_WCONVIN = 159 * MiB, WS_WCONVOUT = 165 * MiB, WS_WPOOL = 167 * MiB;
constexpr size_t WS_HB = 176 * MiB, WS_HH = 240 * MiB, WS_R2 = 416 * MiB, WS_R3 = 480 * MiB, WS_R4 = 544 * MiB, WS_END = 608 * MiB;

struct Params { const float* in[26]; float* out; unsigned char* ws; int lo, hi; };
typedef const __attribute__((address_space(4))) Params* KP;

__device__ __forceinline__ unsigned pk_bf16(float lo, float hi) { f32x2 v = {lo, hi}; bf16x2_t b = __builtin_convertvector(v, bf16x2_t); return __builtin_bit_cast(unsigned, b); }
__device__ __forceinline__ float bf_lo(unsigned w) { return __uint_as_float(w << 16); }
__device__ __forceinline__ float bf_hi(unsigned w) { return __uint_as_float(w & 0xffff0000u); }
__device__ __forceinline__ float wave_sum(float v) {
#pragma unroll
    for (int o = 1; o < 64; o <<= 1) v += __shfl_xor(v, o);
    return v;
}
__device__ __forceinline__ float fast_sigmoid(float x) { return __builtin_amdgcn_rcpf(1.0f + __builtin_amdgcn_exp2f(-x * LOG2E)); }
__device__ __forceinline__ float silu_f(float x) { return x * fast_sigmoid(x); }
__device__ __forceinline__ float gelu_tanh(float y) {
    const float z = 0.7978845608028654f * (y + 0.044715f * y * y * y);
    const float t = 1.0f - 2.0f * __builtin_amdgcn_rcpf(1.0f + __builtin_amdgcn_exp2f(2.0f * LOG2E * z));
    return 0.5f * y * (1.0f + t);
}
__device__ __forceinline__ float log_sigmoid(float z) { return fminf(z, 0.f) - 0.6931471805599453f * __builtin_amdgcn_logf(1.0f + __builtin_amdgcn_exp2f(-fabsf(z) * LOG2E)); }

__device__ __forceinline__ int opaque_tid() { int t = threadIdx.x; asm volatile("" : "+v"(t)); return t; }
namespace pg8 {
constexpr int BM = 256, BK = 64, HALF = 128, HTB = HALF * BK * 2, STAGE_BYTES = 8 * HTB, NXCD = 8, WGM = 8;
__host__ __device__ __forceinline__ int lds_byte(int r, int c) { const int st = (r >> 4) * 2 + (c >> 5), rr = r & 15, cc = c & 31, ob = rr * 64 + cc * 2; return st * 1024 + (ob ^ (((ob >> 9) & 1) << 5)); }
__host__ __device__ __forceinline__ void stage_rc(int b, int& R, int& C) { const int st = b / 1024, sb = b % 1024, swz = sb ^ (((sb >> 9) & 1) << 5); R = (st >> 1) * 16 + swz / 64; C = (st & 1) * 32 + (swz % 64) / 2; }
__host__ __device__ __forceinline__ int perm32(int rho) { const int n = rho >> 4, i = rho & 15; return 8 * (i >> 2) + 4 * n + (i & 3); }
struct Unit { int pm, pn; };
struct Gemm { const bf16_t* A; const bf16_t* Bt; int M, N, K, lda, apn; };
struct StaticOrder {
    int nM, nN, nwg, G, c;
    __device__ void init(int M_, int N_, int G_, int c_) { nM = M_ / BM; nN = N_ / BM; nwg = nM * nN; G = G_; c = c_; }
    __device__ bool next(int i, Unit& u) const {
        const long L = (long)i * G + c; if (L >= nwg) return false;
        int wgid = (int)L; { const int q = nwg / NXCD, r = nwg % NXCD, xcd = wgid % NXCD, off = wgid / NXCD; wgid = (xcd < r ? xcd * (q + 1) : r * (q + 1) + (xcd - r) * q) + off; }
        const int nig = WGM * nN, gid = wgid / nig, fm = gid * WGM, gsz = (nM - fm) < WGM ? (nM - fm) : WGM;
        u.pm = fm + ((wgid % nig) % gsz); u.pn = (wgid % nig) / gsz; return true;
    }
};
template <class Epi>
__device__ __forceinline__ void gemm_phase(LAS unsigned char* lds, const Gemm g, const StaticOrder& S, const Epi& E) {
    const int tid = opaque_tid(), wid = __builtin_amdgcn_readfirstlane(tid >> 6), lane = tid & 63, wr = wid >> 2, wc = wid & 3, fr = lane & 15, fq = lane >> 4;
    const int K = g.K, nt = K / BK;
    unsigned voffA[2], voffB[2];
#pragma unroll
    for (int i = 0; i < 2; ++i) { int R, C; stage_rc(tid * 16 + i * 8192, R, C); const int Rb = (R & ~31) + perm32(R & 31);
        voffA[i] = (unsigned)(R * g.lda + C) * 2u; voffB[i] = (unsigned)(Rb * K + C) * 2u; }
    const size_t kstep = (size_t)(BK * 2);
    const size_t hstepA = (size_t)HALF * g.lda * 2, hstepB = (size_t)HALF * K * 2;
    const size_t tstepA = 2 * hstepA, tstepB = 2 * hstepB;
    const size_t apnb = (size_t)g.apn * 2;
    const unsigned ldsw = (unsigned)wid * 1024u;
    const int aoff = lds_byte(wr * 64 + fr, fq * 8), boff = lds_byte(wc * 32 + fr, fq * 8);
#define PG8_SA(b, h) (((b) * 2 + (h)) * HTB)
#define PG8_SB(b, h) ((4 + (b) * 2 + (h)) * HTB)
#define PG8_STAGE(bufoff, gbase, voff) do { _Pragma("unroll") for (int _i = 0; _i < 2; ++_i) \
        __builtin_amdgcn_global_load_lds((const unsigned*)((const char*)(gbase) + (voff)[_i]), (LAS unsigned*)(lds + (bufoff) + ldsw + _i * 8192), 16, 0, 0); } while (0)
#define PG8_LDA(dst, b, h) do { _Pragma("unroll") for (int m = 0; m < 4; ++m) _Pragma("unroll") for (int k = 0; k < 2; ++k) dst[m][k] = *(const LAS bf16x8*)(lds + PG8_SA(b, h) + aoff + m * 2048 + k * 1024); } while (0)
#define PG8_LDB(dst, b, h) do { _Pragma("unroll") for (int n = 0; n < 2; ++n) _Pragma("unroll") for (int k = 0; k < 2; ++k) dst[n][k] = *(const LAS bf16x8*)(lds + PG8_SB(b, h) + boff + n * 2048 + k * 1024); } while (0)
#define PG8_MMA(ai, bj, At, Bt) do { __builtin_amdgcn_s_setprio(1); _Pragma("unroll") for (int m = 0; m < 4; ++m) _Pragma("unroll") for (int n = 0; n < 2; ++n) _Pragma("unroll") for (int k = 0; k < 2; ++k) \
        acc[ai][bj][m][n] = __builtin_amdgcn_mfma_f32_16x16x32_bf16(Bt[n][k], At[m][k], acc[ai][bj][m][n], 0, 0, 0); __builtin_amdgcn_s_setprio(0); } while (0)
#define PG8_WAIT_V(n) asm volatile("s_waitcnt vmcnt(" #n ")" ::: "memory")
#define PG8_WAIT_L(n) asm volatile("s_waitcnt lgkmcnt(" #n ")" ::: "memory")
#define PG8_BAR __builtin_amdgcn_s_barrier()
#define PG8_SCHED __builtin_amdgcn_sched_barrier(0)
    Unit cur, nxt; int ui = 0;
    if (!S.next(0, cur)) return;
    f32x4 acc[2][2][4][2];
#pragma unroll
    for (int a = 0; a < 2; ++a)
#pragma unroll
        for (int b = 0; b < 2; ++b)
#pragma unroll
            for (int m = 0; m < 4; ++m)
#pragma unroll
                for (int n = 0; n < 2; ++n) acc[a][b][m][n] = (f32x4){0.f, 0.f, 0.f, 0.f};
    bf16x8 At[4][2], B0[2][2], B1[2][2];
    const char* cA = (const char*)g.A + (size_t)cur.pm * tstepA + (size_t)cur.pn * apnb; const char* cB = (const char*)g.Bt + (size_t)cur.pn * tstepB;
    PG8_STAGE(PG8_SB(0, 0), cB, voffB); PG8_STAGE(PG8_SB(0, 1), cB + hstepB, voffB); PG8_STAGE(PG8_SA(0, 0), cA, voffA); PG8_STAGE(PG8_SA(0, 1), cA + hstepA, voffA);
    if (wr == 1) PG8_BAR;
    PG8_WAIT_V(2); PG8_BAR;
    PG8_STAGE(PG8_SB(1, 0), cB + kstep, voffB); PG8_STAGE(PG8_SA(1, 0), cA + kstep, voffA); PG8_STAGE(PG8_SB(1, 1), cB + hstepB + kstep, voffB);
    PG8_WAIT_V(6); PG8_BAR;
    for (;;) {
        const bool has_next = S.next(ui + 1, nxt);
        const char* nA = has_next ? (const char*)g.A + (size_t)nxt.pm * tstepA + (size_t)nxt.pn * apnb : cA; const char* nB = has_next ? (const char*)g.Bt + (size_t)nxt.pn * tstepB : cB;
        for (int t = 0; t < nt; t += 2) {
            const bool last = (t == nt - 2);
            const char* a1 = cA + (size_t)(t + 1) * kstep;
            const char* a2 = last ? nA : cA + (size_t)(t + 2) * kstep; const char* b2 = last ? nB : cB + (size_t)(t + 2) * kstep;
            const char* a3 = a2 + kstep; const char* b3 = b2 + kstep;
            PG8_LDB(B0, 0, 0); PG8_LDB(B1, 0, 1); PG8_SCHED; PG8_LDA(At, 0, 0); PG8_STAGE(PG8_SA(1, 1), a1 + hstepA, voffA);
            PG8_WAIT_V(8); PG8_WAIT_L(0); PG8_BAR; PG8_MMA(0, 0, At, B0); PG8_MMA(0, 1, At, B1); PG8_BAR; PG8_SCHED;
            PG8_LDA(At, 0, 1); PG8_STAGE(PG8_SB(0, 0), b2, voffB); PG8_STAGE(PG8_SB(0, 1), b2 + hstepB, voffB); PG8_STAGE(PG8_SA(0, 0), a2, voffA);
            PG8_WAIT_V(8); PG8_WAIT_L(0); PG8_BAR; PG8_MMA(1, 0, At, B0); PG8_MMA(1, 1, At, B1); PG8_BAR; PG8_SCHED;
            PG8_LDB(B0, 1, 0); PG8_LDB(B1, 1, 1); PG8_SCHED; PG8_LDA(At, 1, 0); PG8_STAGE(PG8_SA(0, 1), a2 + hstepA, voffA);
            PG8_WAIT_V(8); PG8_WAIT_L(0); PG8_BAR; PG8_MMA(0, 0, At, B0); PG8_MMA(0, 1, At, B1); PG8_BAR; PG8_SCHED;
            PG8_LDA(At, 1, 1); PG8_STAGE(PG8_SB(1, 0), b3, voffB); PG8_STAGE(PG8_SB(1, 1), b3 + hstepB, voffB); PG8_STAGE(PG8_SA(1, 0), a3, voffA);
            PG8_WAIT_V(8); PG8_WAIT_L(0); PG8_BAR; PG8_MMA(1, 0, At, B0); PG8_MMA(1, 1, At, B1); PG8_BAR; PG8_SCHED;
        }
        if (wr == 0) PG8_BAR;
        E(acc, cur, wr, wc, fr, fq);
        if (!has_next) break;
#pragma unroll
        for (int a = 0; a < 2; ++a)
#pragma unroll
            for (int b = 0; b < 2; ++b)
#pragma unroll
                for (int m = 0; m < 4; ++m)
#pragma unroll
                    for (int n = 0; n < 2; ++n) acc[a][b][m][n] = (f32x4){0.f, 0.f, 0.f, 0.f};
        cur = nxt; cA = nA; cB = nB; ++ui;
        if (wr == 1) PG8_BAR;
    }
    PG8_WAIT_V(0);
    PG8_BAR;
#undef PG8_SA
#undef PG8_SB
#undef PG8_STAGE
#undef PG8_LDA
#undef PG8_LDB
#undef PG8_MMA
#undef PG8_WAIT_V
#undef PG8_WAIT_L
#undef PG8_BAR
#undef PG8_SCHED
}
}
using pg8::Unit;

typedef const f32x4 (&AccRef)[2][2][4][2];
__device__ __forceinline__ u32x4 pack8(f32x4 a, f32x4 b) { u32x4 w; w.x = pk_bf16(a[0], a[1]); w.y = pk_bf16(a[2], a[3]); w.z = pk_bf16(b[0], b[1]); w.w = pk_bf16(b[2], b[3]); return w; }

struct EpiSwiglu {
    bf16_t* O;
    __device__ __forceinline__ void operator()(AccRef acc, const Unit& u, int wr, int wc, int fr, int fq) const {
        const int row0 = u.pm * 256 + wr * 64 + fr, col0 = u.pn * 128 + wc * 32 + 8 * fq;
#pragma unroll
        for (int ai = 0; ai < 2; ++ai)
#pragma unroll
            for (int m = 0; m < 4; ++m) {
                f32x4 h[2];
#pragma unroll
                for (int n = 0; n < 2; ++n) { const f32x4 gg = acc[ai][0][m][n], uu = acc[ai][1][m][n];
#pragma unroll
                    for (int j = 0; j < 4; ++j) h[n][j] = silu_f(gg[j]) * uu[j]; }
                *(u32x4*)(O + (size_t)(row0 + ai * 128 + m * 16) * DFF + col0) = pack8(h[0], h[1]);
            }
    }
};

struct EpiRes {
    const float* base; float* out; const float* gate; const float* colscale; const bf16_t* glu; float coef; int pad;
    __device__ __forceinline__ void operator()(AccRef acc, const Unit& u, int wr, int wc, int fr, int fq) const {
        const int row0 = u.pm * 256 + wr * 64 + fr, col0 = u.pn * 256 + wc * 32 + 8 * fq;
        const float* gv = gate + (size_t)(u.pm >> 5) * NMOD;
        f32x4 gm[2][2];
#pragma unroll
        for (int bj = 0; bj < 2; ++bj)
#pragma unroll
            for (int n = 0; n < 2; ++n) { const int c = col0 + bj * 128 + 4 * n; f32x4 t = *(const f32x4*)(gv + c); t = (t + 1.0f) * coef;
                if (colscale) t = t * *(const f32x4*)(colscale + c); gm[bj][n] = t; }
#pragma unroll
        for (int ai = 0; ai < 2; ++ai)
#pragma unroll
            for (int m = 0; m < 4; ++m) { const size_t ro = (size_t)(row0 + ai * 128 + m * 16) * D;
#pragma unroll
                for (int bj = 0; bj < 2; ++bj)
#pragma unroll
                    for (int n = 0; n < 2; ++n) { const int c = col0 + bj * 128 + 4 * n; const f32x4 bs = *(const f32x4*)(base + ro + c); f32x4 a = acc[ai][bj][m][n];
                        if (glu) { const u32x2 gw = *(const u32x2*)(glu + ro + c); const f32x4 gg = {bf_lo(gw.x), bf_hi(gw.x), bf_lo(gw.y), bf_hi(gw.y)};
#pragma unroll
                            for (int j = 0; j < 4; ++j) a[j] = gg[j] * fast_sigmoid(a[j]); }
                        *(f32x4*)(out + ro + c) = bs + gm[bj][n] * a; }
                asm volatile("" ::: "memory"); }
    }
};

struct EpiQKV {
    bf16_t *Qo; float* logf; const float *qg, *kg, *bfv;
    __device__ __forceinline__ void operator()(AccRef acc, const Unit& u, int wr, int wc, int fr, int fq) const {
        const int row0 = u.pm * 256 + wr * 64 + fr;
        if (u.pn < 12) {
            const int which = u.pn >> 2, head = 4 * (u.pn & 3) + wc;
            bf16_t* dst = Qo + (size_t)which * ((WS_R3 - WS_R2) / 2);
            const float* gp = which == 0 ? qg : kg; const float gs = which == 0 ? QSCALE : 1.0f;
#pragma unroll
            for (int ai = 0; ai < 2; ++ai)
#pragma unroll
                for (int m = 0; m < 4; ++m) {
                    float rinv = 1.0f;
                    if (which < 2) { float ss = 0.f;
#pragma unroll
                        for (int bj = 0; bj < 2; ++bj)
#pragma unroll
                            for (int n = 0; n < 2; ++n) { const f32x4 a = acc[ai][bj][m][n]; ss += (a[0] * a[0] + a[1] * a[1]) + (a[2] * a[2] + a[3] * a[3]); }
                        ss += __shfl_xor(ss, 16); ss += __shfl_xor(ss, 32);
                        rinv = rsqrtf(ss * (1.0f / 64.0f) + EPS) * gs; }
                    bf16_t* rp = dst + (size_t)(row0 + ai * 128 + m * 16) * D + head * 64 + 8 * fq;
#pragma unroll
                    for (int bj = 0; bj < 2; ++bj) {
                        f32x4 g0 = {1.f, 1.f, 1.f, 1.f}, g1 = g0;
                        if (which < 2) { g0 = *(const f32x4*)(gp + 32 * bj + 8 * fq); g1 = *(const f32x4*)(gp + 32 * bj + 8 * fq + 4); }
                        *(u32x4*)(rp + 32 * bj) = pack8(acc[ai][bj][m][0] * rinv * g0, acc[ai][bj][m][1] * rinv * g1); }
                    asm volatile("" ::: "memory");
                }
        } else if (wc == 0 && fq < 2) {
#pragma unroll
            for (int ai = 0; ai < 2; ++ai)
#pragma unroll
                for (int m = 0; m < 4; ++m)
#pragma unroll
                    for (int n = 0; n < 2; ++n) { const f32x4 bb = *(const f32x4*)(bfv + 8 * fq + 4 * n); f32x4 v = acc[ai][0][m][n] + bb;
#pragma unroll
                        for (int j = 0; j < 4; ++j) v[j] = log_sigmoid(v[j]);
                        *(f32x4*)(logf + (size_t)(row0 + ai * 128 + m * 16) * 16 + 8 * fq + 4 * n) = v; }
        }
    }
};

struct EpiConvIn {
    bf16_t *CZ, *BG;
    __device__ __forceinline__ void operator()(AccRef acc, const Unit& u, int wr, int wc, int fr, int fq) const {
        const int row0 = u.pm * 256 + wr * 64 + fr;
        if (u.pn < 8) {
#pragma unroll
            for (int ai = 0; ai < 2; ++ai)
#pragma unroll
                for (int m = 0; m < 4; ++m)
                    *(u32x4*)(CZ + (size_t)(row0 + ai * 128 + m * 16) * D + u.pn * 128 + wc * 32 + 8 * fq) = pack8(acc[ai][0][m][0] * acc[ai][1][m][0], acc[ai][0][m][1] * acc[ai][1][m][1]);
        } else {
#pragma unroll
            for (int ai = 0; ai < 2; ++ai)
#pragma unroll
                for (int m = 0; m < 4; ++m)
#pragma unroll
                    for (int bj = 0; bj < 2; ++bj)
                        *(u32x4*)(BG + (size_t)(row0 + ai * 128 + m * 16) * D + (u.pn - 8) * 256 + bj * 128 + wc * 32 + 8 * fq) = pack8(acc[ai][bj][m][0], acc[ai][bj][m][1]);
        }
    }
};

__device__ __forceinline__ int colmap(int type, int r) {
    const int pn = r >> 8, c = r & 255;
    if (type == 1) return (c >> 7) * DFF + pn * 128 + (c & 127);
    if (type == 2) return r < 3072 ? pn * 256 + ((c >> 5) & 3) * 64 + (c >> 7) * 32 + (c & 31) : r;
    if (type == 3) return pn < 8 ? 1024 + (c >> 7) * 1024 + pn * 128 + (c & 127) : (pn - 8) * 256 + c;
    return r;
}
__device__ __forceinline__ void transpose_item(const float* W, int ld, int K, bf16_t* WT, int type, int nvalid, LAS float* scr, int kb, int nb, int lane) {
    const int k0 = 64 * kb, n0 = 32 * nb; const int sc = colmap(type, n0) + (lane & 31); const bool ok = sc < nvalid;
#pragma unroll 8
    for (int i = 0; i < 32; ++i) { const int kk = 2 * i + (lane >> 5); scr[kk * 33 + (lane & 31)] = ok ? W[(size_t)(k0 + kk) * ld + sc] : 0.f; }
    asm volatile("s_waitcnt lgkmcnt(0)" ::: "memory");
    const int c = lane & 7;
#pragma unroll
    for (int j = 0; j < 4; ++j) { const int n = (lane >> 3) + 8 * j; const LAS float* s = scr + (8 * c) * 33 + n;
        u32x4 o; o.x = pk_bf16(s[0 * 33], s[1 * 33]); o.y = pk_bf16(s[2 * 33], s[3 * 33]); o.z = pk_bf16(s[4 * 33], s[5 * 33]); o.w = pk_bf16(s[6 * 33], s[7 * 33]);
        *(u32x4*)(WT + (size_t)(n0 + n) * K + k0 + 8 * c) = o; }
    asm volatile("s_waitcnt lgkmcnt(0)" ::: "memory");
}

__device__ __forceinline__ void prologue_phase(KP kp, LAS unsigned char* lds) {
    const int tid = opaque_tid(), lane = tid & 63, wid = tid >> 6, G = gridDim.x;
    unsigned char* ws = kp->ws;
    {
        LAS float* condS = (LAS float*)lds; LAS float* red = (LAS float*)(lds + 16384);
        const float* cin = kp->in[1];
        for (int i = tid; i < 4096; i += NTHREADS) condS[i] = silu_f(cin[i]);
        __syncthreads();
        float* mod = (float*)(ws + WS_MOD);
        const float* ada_w = kp->in[2]; const float* ada_b = kp->in[3];
        for (int it = blockIdx.x; it < 288; it += G) {
            const int l = it / 72, col0 = (it % 72) * 128, cq = tid & 31, kc = tid >> 5;
            f32x4 a0 = {0, 0, 0, 0}, a1 = a0, a2 = a0, a3 = a0;
            const float* wp = ada_w + ((size_t)l * D + kc * 64) * NMOD + col0 + cq * 4;
#pragma unroll 4
            for (int i = 0; i < 64; ++i) { const f32x4 w = *(const f32x4*)(wp + (size_t)i * NMOD); const int k = kc * 64 + i;
                a0 += w * condS[k]; a1 += w * condS[1024 + k]; a2 += w * condS[2048 + k]; a3 += w * condS[3072 + k]; }
            *(LAS f32x4*)(red + (kc * 4 + 0) * 128 + cq * 4) = a0; *(LAS f32x4*)(red + (kc * 4 + 1) * 128 + cq * 4) = a1;
            *(LAS f32x4*)(red + (kc * 4 + 2) * 128 + cq * 4) = a2; *(LAS f32x4*)(red + (kc * 4 + 3) * 128 + cq * 4) = a3;
            __syncthreads();
            { const int b = tid >> 7, col = tid & 127; float s = ada_b[l * NMOD + col0 + col];
#pragma unroll
              for (int k2 = 0; k2 < 16; ++k2) s += red[(k2 * 4 + b) * 128 + col];
              mod[(size_t)(l * 4 + b) * NMOD + col0 + col] = s; }
            __syncthreads();
        }
    }
    __syncthreads();
    {
        LAS float* scr = (LAS float*)(lds + wid * 8448);
        const int gw = blockIdx.x * NWAVES + wid, NGW = G * NWAVES;
        constexpr int I_FIN = 16 * 176, I_FOUT = 44 * 32, I_FOXIN = 16 * 104, I_SQ = 16 * 32, I_CONVIN = 16 * 96, I_POOL = 4 * 8;
        constexpr int NITEMS = 8 * I_FIN + 8 * I_FOUT + I_FOXIN + 3 * I_SQ + I_CONVIN + I_SQ * 0 + 4 * I_POOL;
        for (int it = gw; it < NITEMS; it += NGW) {
            int r = it; const float* src; bf16_t* dst; int K, ld, nd, type = 0, nvalid;
            if (r < 8 * I_FIN) { const int j = r / I_FIN; r %= I_FIN; src = kp->in[5] + (size_t)j * D * 2 * DFF; dst = (bf16_t*)(ws + WS_WFFIN) + (size_t)j * 2 * DFF * D; K = D; ld = 2 * DFF; nd = 2 * DFF; type = 1; nvalid = ld; }
            else if ((r -= 8 * I_FIN) < 8 * I_FOUT) { const int j = r / I_FOUT; r %= I_FOUT; src = kp->in[6] + (size_t)j * DFF * D; dst = (bf16_t*)(ws + WS_WFFOUT) + (size_t)j * D * DFF; K = DFF; ld = D; nd = D; nvalid = ld; }
            else if ((r -= 8 * I_FOUT) < I_FOXIN) { src = kp->in[9]; dst = (bf16_t*)(ws + WS_WFOXIN); K = D; ld = 3 * D + 16; nd = NFOX; type = 2; nvalid = ld; }
            else if ((r -= I_FOXIN) < I_SQ) { src = kp->in[13]; dst = (bf16_t*)(ws + WS_WFOXO); K = D; ld = D; nd = D; nvalid = ld; }
            else if ((r -= I_SQ) < I_SQ) { src = kp->in[22]; dst = (bf16_t*)(ws + WS_WGLU); K = D; ld = D; nd = D; nvalid = ld; }
            else if ((r -= I_SQ) < I_CONVIN) { src = kp->in[23]; dst = (bf16_t*)(ws + WS_WCONVIN); K = D; ld = 3 * D; nd = 3 * D; type = 3; nvalid = ld; }
            else if ((r -= I_CONVIN) < I_SQ) { src = kp->in[25]; dst = (bf16_t*)(ws + WS_WCONVOUT); K = D; ld = D; nd = D; nvalid = ld; }
            else { r -= I_SQ; const int j = r / I_POOL; r %= I_POOL; src = kp->in[7] + (size_t)j * 256 * 256; dst = (bf16_t*)(ws + WS_WPOOL) + (size_t)j * 256 * 256; K = 256; ld = 256; nd = 256; nvalid = ld; }
            const int nblk = nd / 32;
            transpose_item(src, ld, K, dst, type, nvalid, scr, r / nblk, r % nblk, lane);
        }
    }
}

__device__ __forceinline__ void norm_phase(const float* x, bf16_t* hb, const float* gain, const float* modl, int sub) {
    const int tid = opaque_tid(), lane = tid & 63, wid = tid >> 6;
    const int gw = blockIdx.x * NWAVES + wid, NGW = gridDim.x * NWAVES;
    for (int row = gw; row < M; row += NGW) {
        const int b = row >> 13;
        const float* shift = modl + (size_t)b * NMOD + (sub * 3 + 0) * D; const float* scale = shift + D;
        const f32x4* xr = (const f32x4*)(x + (size_t)row * D) + lane;
        f32x4 v[4]; float s = 0.f;
#pragma unroll
        for (int j = 0; j < 4; ++j) { v[j] = xr[64 * j]; s += (v[j][0] * v[j][0] + v[j][1] * v[j][1]) + (v[j][2] * v[j][2] + v[j][3] * v[j][3]); }
        const float r = rsqrtf(wave_sum(s) * (1.0f / D) + EPS);
        u32x2* o8 = (u32x2*)(hb + (size_t)row * D) + lane;
#pragma unroll
        for (int j = 0; j < 4; ++j) { const int c = 4 * (lane + 64 * j);
            const f32x4 g4 = *(const f32x4*)(gain + c), sc = *(const f32x4*)(scale + c), sh = *(const f32x4*)(shift + c);
            const f32x4 o = v[j] * r * g4 * (sc + 1.0f) + sh;
            u32x2 w; w.x = pk_bf16(o[0], o[1]); w.y = pk_bf16(o[2], o[3]); o8[64 * j] = w; }
    }
}

__device__ __forceinline__ void load8(const bf16_t* p, float (&f)[8]) { const u32x4 w = *(const u32x4*)p; f[0] = bf_lo(w.x); f[1] = bf_hi(w.x); f[2] = bf_lo(w.y); f[3] = bf_hi(w.y); f[4] = bf_lo(w.z); f[5] = bf_hi(w.z); f[6] = bf_lo(w.w); f[7] = bf_hi(w.w); }
__device__ __forceinline__ void store8(bf16_t* p, const float (&f)[8]) { u32x4 w; w.x = pk_bf16(f[0], f[1]); w.y = pk_bf16(f[2], f[3]); w.z = pk_bf16(f[4], f[5]); w.w = pk_bf16(f[6], f[7]); *(u32x4*)p = w; }
__device__ __forceinline__ void pool_phase(const bf16_t* hb, bf16_t* pooled) {
    const int tid = opaque_tid();
    for (int wi = blockIdx.x; wi < 512; wi += gridDim.x) {
        const int rb = wi * 4 + (tid >> 7), o = tid & 127, w = 2 << (o >> 5);
        const int row0 = rb * 16, t0 = row0 & (SEQ - 1);
        const bf16_t* hp = hb + (size_t)row0 * D + o * 8;
        float sum[8], cur[8], old[8];
#pragma unroll
        for (int j = 0; j < 8; ++j) sum[j] = 0.f;
        for (int k = 1; k < w; ++k) if (t0 - k >= 0) { load8(hp - (size_t)k * D, old);
#pragma unroll
            for (int j = 0; j < 8; ++j) sum[j] += old[j]; }
        for (int tt = 0; tt < 16; ++tt) {
            const int t = t0 + tt; load8(hp + (size_t)tt * D, cur);
            const float inv = 1.0f / (float)((t + 1) < w ? (t + 1) : w);
            float ov[8];
#pragma unroll
            for (int j = 0; j < 8; ++j) { sum[j] += cur[j]; ov[j] = sum[j] * inv - cur[j]; }
            store8(pooled + (size_t)(row0 + tt) * D + o * 8, ov);
            if (t - w + 1 >= 0) { load8(hp + (size_t)(tt - w + 1) * D, old);
#pragma unroll
                for (int j = 0; j < 8; ++j) sum[j] -= old[j]; }
        }
    }
}

__device__ __forceinline__ void conv_phase(const bf16_t* cz, const bf16_t* bg, const float* cw, bf16_t* a2) {
    const int tid = opaque_tid(), o = tid & 127;
    float w0[8], w1[8], w2[8];
#pragma unroll
    for (int j = 0; j < 8; ++j) { w0[j] = cw[o * 8 + j]; w1[j] = cw[D + o * 8 + j]; w2[j] = cw[2 * D + o * 8 + j]; }
    for (int wi = blockIdx.x; wi < M / 4; wi += gridDim.x) {
        const int row = wi * 4 + (tid >> 7), t = row & (SEQ - 1);
        const size_t off = (size_t)row * D + o * 8;
        float x0[8], x1[8], x2[8], b[8], ov[8];
        load8(cz + off, x2); load8(bg + off, b);
        if (t >= 1) load8(cz + off - D, x1); else {
#pragma unroll
            for (int j = 0; j < 8; ++j) x1[j] = 0.f; }
        if (t >= 2) load8(cz + off - 2 * D, x0); else {
#pragma unroll
            for (int j = 0; j < 8; ++j) x0[j] = 0.f; }
#pragma unroll
        for (int j = 0; j < 8; ++j) ov[j] = b[j] * (w0[j] * x0[j] + w1[j] * x1[j] + w2[j] * x2[j]);
        store8(a2 + off, ov);
    }
}

__device__ __forceinline__ void cumsum_phase(const float* logf, float* biasK, LAS unsigned char* lds) {
    const int tid = opaque_tid(), lane = tid & 63, wid = tid >> 6;
    LAS float* wtot = (LAS float*)lds;
    for (int it = blockIdx.x; it < 64; it += gridDim.x) {
        const int b = it >> 4, h = it & 15;
        const size_t base = ((size_t)b * SEQ + tid * 16) * 16 + h;
        float v[16];
#pragma unroll
        for (int i = 0; i < 16; ++i) v[i] = logf[base + (size_t)i * 16];
#pragma unroll
        for (int i = 1; i < 16; ++i) v[i] += v[i - 1];
        float inc = v[15];
#pragma unroll
        for (int o = 1; o < 64; o <<= 1) { const float t = __shfl_up(inc, o); if (lane >= o) inc += t; }
        if (lane == 63) wtot[wid] = inc;
        __syncthreads();
        float off = inc - v[15];
        for (int w2 = 0; w2 < wid; ++w2) off += wtot[w2];
#pragma unroll
        for (int i = 0; i < 16; ++i) biasK[base + (size_t)i * 16] = -LOG2E * (v[i] + off);
        __syncthreads();
    }
}

__device__ __forceinline__ int crow(int r, int hi) { return (r & 3) + 8 * (r >> 2) + 4 * hi; }
__device__ __forceinline__ void attn_phase(LAS unsigned char* lds, const bf16_t* Q, const bf16_t* Kg, const bf16_t* Vg, bf16_t* O, const float* biasK) {
    const int tid = opaque_tid(), lane = tid & 63, wid = __builtin_amdgcn_readfirstlane(tid >> 6), r32 = lane & 31, hi = lane >> 5;
    const int G = gridDim.x, c = blockIdx.x;
    constexpr int ROWB = 144, KT = 64 * ROWB, BUF = 2 * KT + 256;
    const int kvr = tid >> 3, ch = tid & 7;
    const int slot = (kvr & ~15) | (kvr & 3) | ((kvr & 4) << 1) | ((kvr & 8) >> 1);
    for (int i = 0; i * G < 2048; ++i) {
        const int pidx = i * G + ((i & 1) ? (G - 1 - c) : c);
        if (pidx >= 2048) continue;
        const int qb = 31 - (pidx >> 6), bh = pidx & 63, b = bh >> 4, h = bh & 15;
        const int q0 = qb * 256, NT = 4 * qb + 4;
        const size_t rowbase = (size_t)b * SEQ;
        const int qloc = q0 + wid * 32 + r32;
        bf16x8 qr[4];
#pragma unroll
        for (int d0 = 0; d0 < 4; ++d0) qr[d0] = *(const bf16x8*)(Q + (rowbase + qloc) * D + h * 64 + d0 * 16 + hi * 8);
        const float ref = biasK[(rowbase + q0 + 255) * 16 + h];
        const bf16_t* kp = Kg + (rowbase + kvr) * D + h * 64 + ch * 8;
        const bf16_t* vp = Vg + (rowbase + kvr) * D + h * 64 + ch * 8;
        const float* bp = biasK + (rowbase + (tid & 63)) * 16 + h;
        u32x4 kreg = *(const u32x4*)kp, vreg = *(const u32x4*)vp; float breg = (tid < 64) ? bp[0] - ref : 0.f;
#define ATT_WRITE(bufi) do { LAS unsigned char* bb_ = lds + (bufi) * BUF; \
            *(LAS u32x4*)(bb_ + kvr * ROWB + ch * 16) = kreg; \
            LAS bf16_t* vt_ = (LAS bf16_t*)(bb_ + KT) + (ch * 8) * (ROWB / 2) + slot; \
            vt_[0 * (ROWB / 2)] = (bf16_t)(vreg.x & 0xffff); vt_[1 * (ROWB / 2)] = (bf16_t)(vreg.x >> 16); \
            vt_[2 * (ROWB / 2)] = (bf16_t)(vreg.y & 0xffff); vt_[3 * (ROWB / 2)] = (bf16_t)(vreg.y >> 16); \
            vt_[4 * (ROWB / 2)] = (bf16_t)(vreg.z & 0xffff); vt_[5 * (ROWB / 2)] = (bf16_t)(vreg.z >> 16); \
            vt_[6 * (ROWB / 2)] = (bf16_t)(vreg.w & 0xffff); vt_[7 * (ROWB / 2)] = (bf16_t)(vreg.w >> 16); \
            if (tid < 64) ((LAS float*)(bb_ + 2 * KT))[tid] = breg; } while (0)
        ATT_WRITE(0);
        __syncthreads();
        float mrun = -1e30f, lrun = 0.f;
        f32x16 oT[2];
#pragma unroll
        for (int r = 0; r < 16; ++r) { oT[0][r] = 0.f; oT[1][r] = 0.f; }
        for (int t = 0; t < NT; ++t) {
            const int cur = t & 1;
            if (t + 1 < NT) { kreg = *(const u32x4*)(kp + (size_t)(t + 1) * 64 * D); vreg = *(const u32x4*)(vp + (size_t)(t + 1) * 64 * D); if (tid < 64) breg = bp[(size_t)(t + 1) * 64 * 16] - ref; }
            const int wq0 = q0 + wid * 32;
            if (64 * t <= wq0 + 31) {
                LAS unsigned char* bb = lds + cur * BUF;
                const LAS float* bias = (const LAS float*)(bb + 2 * KT);
                f32x16 p0, p1;
#pragma unroll
                for (int g4 = 0; g4 < 4; ++g4) { const f32x4 b0 = *(const LAS f32x4*)(bias + 8 * g4 + 4 * hi), b1 = *(const LAS f32x4*)(bias + 32 + 8 * g4 + 4 * hi);
#pragma unroll
                    for (int j = 0; j < 4; ++j) { p0[4 * g4 + j] = b0[j]; p1[4 * g4 + j] = b1[j]; } }
#pragma unroll
                for (int d0 = 0; d0 < 4; ++d0) {
                    const bf16x8 k0 = *(const LAS bf16x8*)(bb + r32 * ROWB + d0 * 32 + hi * 16);
                    const bf16x8 k1 = *(const LAS bf16x8*)(bb + (32 + r32) * ROWB + d0 * 32 + hi * 16);
                    p0 = __builtin_amdgcn_mfma_f32_32x32x16_bf16(k0, qr[d0], p0, 0, 0, 0);
                    p1 = __builtin_amdgcn_mfma_f32_32x32x16_bf16(k1, qr[d0], p1, 0, 0, 0);
                }
                if (64 * t + 63 > wq0) {
#pragma unroll
                    for (int r = 0; r < 16; ++r) { const int kv = 64 * t + crow(r, hi); if (kv > qloc) p0[r] = -1e30f; if (kv + 32 > qloc) p1[r] = -1e30f; }
                }
                float mt = fmaxf(p0[0], p1[0]);
#pragma unroll
                for (int r = 1; r < 16; ++r) mt = fmaxf(mt, fmaxf(p0[r], p1[r]));
                mt = fmaxf(mt, __shfl_xor(mt, 32));
                const float mnew = fmaxf(mrun, mt);
                const float alpha = __builtin_amdgcn_exp2f(mrun - mnew);
                mrun = mnew;
                float ls = 0.f;
#pragma unroll
                for (int r = 0; r < 16; ++r) { p0[r] = __builtin_amdgcn_exp2f(p0[r] - mnew); p1[r] = __builtin_amdgcn_exp2f(p1[r] - mnew); ls += p0[r] + p1[r]; }
                lrun = lrun * alpha + ls;
#pragma unroll
                for (int r = 0; r < 16; ++r) { oT[0][r] *= alpha; oT[1][r] *= alpha; }
                bf16x8 pf[4];
                { u32x4 w;
                  w.x = pk_bf16(p0[0], p0[1]); w.y = pk_bf16(p0[2], p0[3]); w.z = pk_bf16(p0[4], p0[5]); w.w = pk_bf16(p0[6], p0[7]); pf[0] = __builtin_bit_cast(bf16x8, w);
                  w.x = pk_bf16(p0[8], p0[9]); w.y = pk_bf16(p0[10], p0[11]); w.z = pk_bf16(p0[12], p0[13]); w.w = pk_bf16(p0[14], p0[15]); pf[1] = __builtin_bit_cast(bf16x8, w);
                  w.x = pk_bf16(p1[0], p1[1]); w.y = pk_bf16(p1[2], p1[3]); w.z = pk_bf16(p1[4], p1[5]); w.w = pk_bf16(p1[6], p1[7]); pf[2] = __builtin_bit_cast(bf16x8, w);
                  w.x = pk_bf16(p1[8], p1[9]); w.y = pk_bf16(p1[10], p1[11]); w.z = pk_bf16(p1[12], p1[13]); w.w = pk_bf16(p1[14], p1[15]); pf[3] = __builtin_bit_cast(bf16x8, w); }
                const LAS unsigned char* vt = bb + KT;
#pragma unroll
                for (int db = 0; db < 2; ++db)
#pragma unroll
                    for (int cc = 0; cc < 4; ++cc) {
                        const bf16x8 vf = *(const LAS bf16x8*)(vt + (32 * db + r32) * ROWB + cc * 32 + hi * 16);
                        oT[db] = __builtin_amdgcn_mfma_f32_32x32x16_bf16(vf, pf[cc], oT[db], 0, 0, 0);
                    }
            }
            if (t + 1 < NT) ATT_WRITE(cur ^ 1);
            __syncthreads();
        }
#undef ATT_WRITE
        const float ltot = lrun + __shfl_xor(lrun, 32);
        const float rl = 1.0f / ltot;
        bf16_t* op = O + (rowbase + qloc) * D + h * 64;
#pragma unroll
        for (int db = 0; db < 2; ++db)
#pragma unroll
            for (int g4 = 0; g4 < 4; ++g4) { u32x2 w; w.x = pk_bf16(oT[db][4 * g4] * rl, oT[db][4 * g4 + 1] * rl); w.y = pk_bf16(oT[db][4 * g4 + 2] * rl, oT[db][4 * g4 + 3] * rl);
                *(u32x2*)(op + 32 * db + 8 * g4 + 4 * hi) = w; }
    }
}

template <bool PASS_B>
__device__ __forceinline__ void s5_phase(KP kp, LAS unsigned char* lds, const bf16_t* hb, f32x2* Ebuf, bf16_t* gout) {
    const int tid = opaque_tid(), lane = tid & 63, wid = __builtin_amdgcn_readfirstlane(tid >> 6);
    LAS float* uS = (LAS float*)(lds + wid * 8192);
    LAS float* xS = (LAS float*)(lds + 65536 + wid * 4224);
    LAS float* cS = (LAS float*)(lds + 65536 + 8 * 4224);
    const float *lam_re = kp->in[14], *lam_im = kp->in[15], *log_dt = kp->in[16], *b_re = kp->in[17], *b_im = kp->in[18], *c_re = kp->in[19], *c_im = kp->in[20], *d_skip = kp->in[21];
    for (int it = blockIdx.x; it < 2048; it += gridDim.x) {
        const int g = it & 63, co = (it >> 6) & 7, b = it >> 9, ck = co * 8 + wid;
        const size_t row0 = (size_t)b * SEQ + ck * 128;
#pragma unroll
        for (int j = 0; j < 4; ++j) { const int tl = (lane >> 1) + 32 * j, hf = lane & 1; float f[8]; load8(hb + (row0 + tl) * D + 16 * g + 8 * hf, f);
            *(LAS f32x4*)(uS + tl * 16 + 8 * hf) = (f32x4){f[0], f[1], f[2], f[3]}; *(LAS f32x4*)(uS + tl * 16 + 8 * hf + 4) = (f32x4){f[4], f[5], f[6], f[7]}; }
        if (PASS_B) {
            for (int e = tid; e < 16 * 128; e += NTHREADS) { const int i = e >> 7, n = e & 127;
                cS[i * 132 + n] = n < 64 ? c_re[((size_t)g * 16 + i) * 64 + n] : -c_im[((size_t)g * 16 + i) * 64 + (n - 64)]; }
        }
        const int gn = g * 64 + lane;
        const float dt = __expf(log_dt[g]);
        const float ar = lam_re[gn], ai = lam_im[gn];
        const float mag = __expf(ar * dt);
        float th = ai * dt; { const float kq = rintf(th * 0.15915494309189535f); th = fmaf(-kq, 6.28318548202514648f, th); th = fmaf(-kq, -1.7484555e-7f, th); }
        const float lbr = mag * cosf(th), lbi = mag * sinf(th);
        const float den = ar * ar + ai * ai, nr = lbr - 1.0f, ni = lbi;
        const float kr = (nr * ar + ni * ai) / den, ki = (ni * ar - nr * ai) / den;
        float bbr[16], bbi[16];
#pragma unroll
        for (int q4 = 0; q4 < 4; ++q4) { const f32x4 br = *(const f32x4*)(b_re + (size_t)gn * 16 + 4 * q4), bi = *(const f32x4*)(b_im + (size_t)gn * 16 + 4 * q4);
#pragma unroll
            for (int j = 0; j < 4; ++j) { bbr[4 * q4 + j] = kr * br[j] - ki * bi[j]; bbi[4 * q4 + j] = kr * bi[j] + ki * br[j]; } }
        float xr = 0.f, xi = 0.f;
        if (PASS_B) {
            float pr = lbr, pi = lbi;
#pragma unroll
            for (int s = 0; s < 7; ++s) { const float t = pr * pr - pi * pi; pi = 2.0f * pr * pi; pr = t; }
            const f32x2* Ep = Ebuf + (((size_t)b * 64 + g) * 64) * 64 + lane;
            for (int c2 = 0; c2 < ck; ++c2) { const f32x2 e = Ep[(size_t)c2 * 64]; const float t = pr * xr - pi * xi + e.x; xi = pr * xi + pi * xr + e.y; xr = t; }
        }
        __syncthreads();
        if (!PASS_B) {
            for (int t = 0; t < 128; ++t) {
                const LAS f32x4* up = (const LAS f32x4*)(uS + t * 16);
                float sr = 0.f, si = 0.f;
#pragma unroll
                for (int q4 = 0; q4 < 4; ++q4) { const f32x4 u4 = up[q4];
#pragma unroll
                    for (int j = 0; j < 4; ++j) { sr = fmaf(bbr[4 * q4 + j], u4[j], sr); si = fmaf(bbi[4 * q4 + j], u4[j], si); } }
                const float t2 = lbr * xr - lbi * xi + sr; xi = lbr * xi + lbi * xr + si; xr = t2;
            }
            Ebuf[((((size_t)b * 64 + g) * 64) + ck) * 64 + lane] = (f32x2){xr, xi};
        } else {
            const int oi = lane & 15, tq = lane >> 4;
            const float dsk = d_skip[16 * g + oi];
            for (int sb = 0; sb < 16; ++sb) {
#pragma unroll
                for (int tl = 0; tl < 8; ++tl) {
                    const LAS f32x4* up = (const LAS f32x4*)(uS + (sb * 8 + tl) * 16);
                    float sr = 0.f, si = 0.f;
#pragma unroll
                    for (int q4 = 0; q4 < 4; ++q4) { const f32x4 u4 = up[q4];
#pragma unroll
                        for (int j = 0; j < 4; ++j) { sr = fmaf(bbr[4 * q4 + j], u4[j], sr); si = fmaf(bbi[4 * q4 + j], u4[j], si); } }
                    const float t2 = lbr * xr - lbi * xi + sr; xi = lbr * xi + lbi * xr + si; xr = t2;
                    xS[tl * 132 + lane] = xr; xS[tl * 132 + 64 + lane] = xi;
                }
                asm volatile("s_waitcnt lgkmcnt(0)" ::: "memory");
                float y0 = 0.f, y1 = 0.f;
                const LAS f32x4* cp = (const LAS f32x4*)(cS + oi * 132);
                const LAS f32x4* x0p = (const LAS f32x4*)(xS + tq * 132);
                const LAS f32x4* x1p = (const LAS f32x4*)(xS + (tq + 4) * 132);
#pragma unroll 8
                for (int n4 = 0; n4 < 32; ++n4) { const f32x4 cv = cp[n4], xa = x0p[n4], xb = x1p[n4];
                    y0 += (cv[0] * xa[0] + cv[1] * xa[1]) + (cv[2] * xa[2] + cv[3] * xa[3]);
                    y1 += (cv[0] * xb[0] + cv[1] * xb[1]) + (cv[2] * xb[2] + cv[3] * xb[3]); }
                const int ta = sb * 8 + tq, tb = ta + 4;
                y0 += dsk * uS[ta * 16 + oi]; y1 += dsk * uS[tb * 16 + oi];
                gout[(row0 + ta) * D + 16 * g + oi] = (bf16_t)(pk_bf16(gelu_tanh(y0), 0.f) & 0xffff);
                gout[(row0 + tb) * D + 16 * g + oi] = (bf16_t)(pk_bf16(gelu_tanh(y1), 0.f) & 0xffff);
                asm volatile("s_waitcnt lgkmcnt(0)" ::: "memory");
            }
        }
        __syncthreads();
    }
}

enum Kind { K_PROLOGUE, K_NORM, K_FFNIN, K_FFNOUT, K_POOL_EW, K_POOL_GEMM, K_QKV, K_CUMSUM, K_ATTN, K_WO, K_S5A, K_S5B, K_GLU, K_CONVIN, K_CONV_EW, K_CONVOUT };
constexpr int NPHASES = 1 + 9 + 11 + 10 + 10;
__host__ __device__ inline void decode_phase(int ph, int& layer, int& kind, int& sub) {
    layer = 0; sub = 0; kind = K_PROLOGUE; if (ph == 0) return;
    int r = ph - 1;
    for (int l = 0; l < 4; ++l) {
        const int nm = (l == 0) ? 2 : (l == 1 ? 4 : 3), n = 7 + nm;
        if (r < n) { layer = l;
            if (r < 3) { sub = 0; kind = r == 0 ? K_NORM : (r == 1 ? K_FFNIN : K_FFNOUT); }
            else if (r == 3) { sub = 1; kind = K_NORM; }
            else if (r < 4 + nm) { sub = 1; const int q = r - 4;
                kind = l == 0 ? (q == 0 ? K_POOL_EW : K_POOL_GEMM) : l == 1 ? (q == 0 ? K_QKV : q == 1 ? K_CUMSUM : q == 2 ? K_ATTN : K_WO)
                     : l == 2 ? (q == 0 ? K_S5A : q == 1 ? K_S5B : K_GLU) : (q == 0 ? K_CONVIN : q == 1 ? K_CONV_EW : K_CONVOUT); }
            else { sub = 2; const int q = r - 4 - nm; kind = q == 0 ? K_NORM : (q == 1 ? K_FFNIN : K_FFNOUT); }
            return; }
        r -= n;
    }
}

__global__ void __launch_bounds__(NTHREADS, 2) mega_fwd(Params p_arg) {
    extern __shared__ __attribute__((aligned(16))) unsigned char lds_raw[];
    LAS unsigned char* lds = (LAS unsigned char*)lds_raw;
    cg::grid_group grid = cg::this_grid();
    const KP kp0 = (KP)__builtin_amdgcn_kernarg_segment_ptr();
    const int lo = kp0->lo, hi = kp0->hi;
    for (int ph = lo; ph < hi; ++ph) {
        KP kp = kp0; asm volatile("" : "+s"(kp));
        int layer, kind, sub; decode_phase(ph, layer, kind, sub);
        unsigned char* ws = kp->ws;
        float* xout = kp->out;
        const float* modl = (const float*)(ws + WS_MOD) + (size_t)layer * 4 * NMOD;
        const bool first = (layer == 0 && sub == 0);
        const float* xcur = first ? kp->in[0] : xout;
        const int ffi = layer * 2 + (sub == 2 ? 1 : 0);
        bf16_t* HB = (bf16_t*)(ws + WS_HB); bf16_t* HH = (bf16_t*)(ws + WS_HH);
        bf16_t* R2 = (bf16_t*)(ws + WS_R2); bf16_t* R3 = (bf16_t*)(ws + WS_R3); bf16_t* R4 = (bf16_t*)(ws + WS_R4);
        float* logf = (float*)(ws + WS_LOGF); float* biasK = (float*)(ws + WS_BIASK);
        if (kind == K_PROLOGUE) prologue_phase(kp, lds);
        else if (kind == K_NORM) norm_phase(xcur, HB, kp->in[4] + (size_t)(layer * 3 + sub) * D, modl, sub);
        else if (kind == K_FFNIN) {
            const pg8::Gemm g{HB, (const bf16_t*)(ws + WS_WFFIN) + (size_t)ffi * 2 * DFF * D, M, 2 * DFF, D, D, 0};
            pg8::StaticOrder S; S.init(M, 2 * DFF, gridDim.x, blockIdx.x);
            const EpiSwiglu E{HH};
            pg8::gemm_phase<EpiSwiglu>(lds, g, S, E);
        } else if (kind == K_QKV) {
            const pg8::Gemm g{HB, (const bf16_t*)(ws + WS_WFOXIN), M, NFOX, D, D, 0};
            pg8::StaticOrder S; S.init(M, NFOX, gridDim.x, blockIdx.x);
            const EpiQKV E{R2, logf, kp->in[11], kp->in[12], kp->in[10]};
            pg8::gemm_phase<EpiQKV>(lds, g, S, E);
        } else if (kind == K_CONVIN) {
            const pg8::Gemm g{HB, (const bf16_t*)(ws + WS_WCONVIN), M, 3 * D, D, D, 0};
            pg8::StaticOrder S; S.init(M, 3 * D, gridDim.x, blockIdx.x);
            const EpiConvIn E{R2, R3};
            pg8::gemm_phase<EpiConvIn>(lds, g, S, E);
        } else if (kind == K_FFNOUT || kind == K_POOL_GEMM || kind == K_WO || kind == K_GLU || kind == K_CONVOUT) {
            const bf16_t* A = R2; const bf16_t* Bt; int K = D, lda = D, apn = 0; float coef = 1.0f; const float* colscale = nullptr; const bf16_t* glu = nullptr;
            if (kind == K_FFNOUT) { A = HH; Bt = (const bf16_t*)(ws + WS_WFFOUT) + (size_t)ffi * D * DFF; K = DFF; lda = DFF; coef = 0.5f; }
            else if (kind == K_POOL_GEMM) { Bt = (const bf16_t*)(ws + WS_WPOOL); K = 256; apn = 256; colscale = kp->in[8]; }
            else if (kind == K_WO) { Bt = (const bf16_t*)(ws + WS_WFOXO); }
            else if (kind == K_GLU) { Bt = (const bf16_t*)(ws + WS_WGLU); glu = R2; }
            else { A = R4; Bt = (const bf16_t*)(ws + WS_WCONVOUT); }
            const pg8::Gemm g{A, Bt, M, D, K, lda, apn};
            const EpiRes E{xcur, xout, modl + (sub * 3 + 2) * D, colscale, glu, coef, 0};
            pg8::StaticOrder S; S.init(M, D, gridDim.x, blockIdx.x);
            pg8::gemm_phase<EpiRes>(lds, g, S, E);
        }
        else if (kind == K_POOL_EW) pool_phase(HB, R2);
        else if (kind == K_CUMSUM) cumsum_phase(logf, biasK, lds);
        else if (kind == K_ATTN) attn_phase(lds, R2, R3, R4, R2, biasK);
        else if (kind == K_S5A) s5_phase<false>(kp, lds, HB, (f32x2*)(ws + WS_E), R2);
        else if (kind == K_S5B) s5_phase<true>(kp, lds, HB, (f32x2*)(ws + WS_E), R2);
        else if (kind == K_CONV_EW) conv_phase(R2, R3, kp->in[24], R4);
        if (ph + 1 < hi) grid.sync();
    }
}

extern "C" void kernel_launch(void* const* d_in, const int* in_sizes, int n_in, void* d_out, int out_size, void* d_ws, size_t ws_size, hipStream_t stream) {
    static int grid = 0;
    if (grid == 0) {
        if (n_in != 26 || out_size != M * D || ws_size < WS_END) { fprintf(stderr, "kernel_launch: unexpected shapes (n_in %d out %d ws %zu)\n", n_in, out_size, ws_size); grid = -1; return; }
        int dev = 0, cus = 0, per_cu = 0;
        (void)hipGetDevice(&dev); (void)hipDeviceGetAttribute(&cus, hipDeviceAttributeMultiprocessorCount, dev);
        if (hipFuncSetAttribute((const void*)mega_fwd, hipFuncAttributeMaxDynamicSharedMemorySize, LDS_BYTES) != hipSuccess) { fprintf(stderr, "kernel_launch: hipFuncSetAttribute failed\n"); grid = -1; return; }
        if (hipOccupancyMaxActiveBlocksPerMultiprocessor(&per_cu, (const void*)mega_fwd, NTHREADS, LDS_BYTES) != hipSuccess || per_cu < 1) { fprintf(stderr, "kernel_launch: occupancy query gave %d\n", per_cu); per_cu = 1; }
        (void)hipGetLastError();
        grid = cus * per_cu;
        fprintf(stderr, "kernel_launch: grid %d (cus %d x %d)\n", grid, cus, per_cu);
    }
    if (grid < 0) return;
    Params p{};
    for (int i = 0; i < 26; ++i) p.in[i] = (const float*)d_in[i];
    p.out = (float*)d_out; p.ws = (unsigned char*)d_ws;
#if MK_ONE_LAUNCH
    p.lo = 0; p.hi = NPHASES;
    void* args[] = {&p};
    hipError_t e = hipLaunchCooperativeKernel((const void*)mega_fwd, dim3(grid), dim3(NTHREADS), args, LDS_BYTES, stream);
    if (e != hipSuccess) fprintf(stderr, "cooperative launch failed: %s (grid %d)\n", hipGetErrorString(e), grid);
#else
    for (int ph = 0; ph < NPHASES; ++ph) {
        p.lo = ph; p.hi = ph + 1;
        hipLaunchKernelGGL(mega_fwd, dim3(grid), dim3(NTHREADS), LDS_BYTES, stream, p);
    }
#endif
}
```

```cpp
#include <hip/hip_runtime.h>
#include <hip/hip_cooperative_groups.h>
#include <cstdio>
#include <cstdint>
namespace cg = cooperative_groups;

#ifndef REPMASK
#define REPMASK 0
#endif
#ifndef MK_ONE_LAUNCH
#define MK_ONE_LAUNCH 1
#endif

#define LAS __attribute__((address_space(3)))
typedef unsigned short bf16_t;
typedef short bf16x8 __attribute__((ext_vector_type(8)));
typedef float f32x4 __attribute__((ext_vector_type(4)));
typedef float f32x2 __attribute__((ext_vector_type(2)));
typedef float f32x16 __attribute__((ext_vector_type(16)));
typedef unsigned u32x4 __attribute__((ext_vector_type(4)));
typedef unsigned u32x2 __attribute__((ext_vector_type(2)));
typedef __bf16 bf16x2_t __attribute__((ext_vector_type(2)));
typedef _Float16 h16x4 __attribute__((ext_vector_type(4)));

constexpr int D = 1024, BATCH = 4, SEQ = 8192, M = BATCH * SEQ, DFF = 2816, NMOD = 9 * D;
constexpr int NFOX = 3328;
constexpr float EPS = 1e-6f;
constexpr float LOG2E = 1.4426950408889634f;
constexpr float QSCALE = 0.125f * LOG2E;
constexpr int NTHREADS = 512, NWAVES = 8;
constexpr int LDS_MAIN = 131072, LDS_SSL = 16384 + 2048, LDS_BYTES = LDS_MAIN + LDS_SSL + 64;

constexpr size_t MiB = 1u << 20;
constexpr size_t WS_MOD = 0, WS_LOGF = 1 * MiB, WS_BIASK = 3 * MiB, WS_E = 5 * MiB, WS_BAR = 13 * MiB, BAR_BYTES = 16384;
constexpr size_t WS_WFFIN = 16 * MiB, WS_WFFOUT = 104 * MiB, WS_WFOXIN = 148 * MiB, WS_WFOXO = 155 * MiB, WS_WGLU = 157 * MiB,
                 WS_WCONVIN = 159 * MiB, WS_WCONVOUT = 165 * MiB, WS_WPOOL = 167 * MiB;
constexpr size_t WS_SS = 172 * MiB, WS_BIASV = 170 * MiB, WS_GS = 171 * MiB;
constexpr int BV_FFN = 4 * 2 * DFF, BV_QKV_OFF = 8 * BV_FFN, BV_CONV_OFF = BV_QKV_OFF + 4 * NFOX, BV_TOTAL = BV_CONV_OFF + 4 * 3 * D;
constexpr size_t WS_HB = 176 * MiB, WS_HH = 240 * MiB, WS_R2 = 416 * MiB, WS_R3 = 480 * MiB, WS_R4 = 544 * MiB, WS_XH = 608 * MiB, WS_END = 672 * MiB;

struct Params { const float* in[26]; float* out; unsigned char* ws; int lo, hi; };
typedef const __attribute__((address_space(4))) Params* KP;

__device__ __forceinline__ unsigned pk_bf16(float lo, float hi) { f32x2 v = {lo, hi}; bf16x2_t b = __builtin_convertvector(v, bf16x2_t); return __builtin_bit_cast(unsigned, b); }
__device__ __forceinline__ float bf_lo(unsigned w) { return __uint_as_float(w << 16); }
__device__ __forceinline__ float bf_hi(unsigned w) { return __uint_as_float(w & 0xffff0000u); }
__device__ __forceinline__ float wave_sum(float v) {
#pragma unroll
    for (int o = 1; o < 64; o <<= 1) v += __shfl_xor(v, o);
    return v;
}
__device__ __forceinline__ float fast_sigmoid(float x) { return __builtin_amdgcn_rcpf(1.0f + __builtin_amdgcn_exp2f(-x * LOG2E)); }
__device__ __forceinline__ float silu_f(float x) { return x * fast_sigmoid(x); }
__device__ __forceinline__ float gelu_tanh(float y) {
    const float z = 0.7978845608028654f * (y + 0.044715f * y * y * y);
    const float t = 1.0f - 2.0f * __builtin_amdgcn_rcpf(1.0f + __builtin_amdgcn_exp2f(2.0f * LOG2E * z));
    return 0.5f * y * (1.0f + t);
}
__device__ __forceinline__ float rs_of(float ss) { return rsqrtf(ss * (1.0f / D) + EPS); }
__device__ __forceinline__ float rs_row(const float* ssp, size_t row) { float t = 0.f;
#pragma unroll
    for (int pn = 0; pn < 4; ++pn) { const f32x4 v = *(const f32x4*)(ssp + ((size_t)pn * M + row) * 4); t += (v[0] + v[1]) + (v[2] + v[3]); }
    return rs_of(t); }
__device__ __forceinline__ float log_sigmoid(float z) { return fminf(z, 0.f) - 0.6931471805599453f * __builtin_amdgcn_logf(1.0f + __builtin_amdgcn_exp2f(-fabsf(z) * LOG2E)); }

__device__ __forceinline__ int opaque_tid() { int t = threadIdx.x; asm volatile("" : "+v"(t)); return t; }
template <int OFF> __device__ __forceinline__ void gld16(f32x4& v, const void* p) { asm volatile("global_load_dwordx4 %0, %1, off offset:%2" : "=&v"(v) : "v"(p), "i"(OFF) : "memory"); }
template <int OFF> __device__ __forceinline__ void gld8(u32x2& v, const void* p) { asm volatile("global_load_dwordx2 %0, %1, off offset:%2" : "=&v"(v) : "v"(p), "i"(OFF) : "memory"); }
__device__ __forceinline__ void gwait8(f32x4 (&v)[8]) { asm volatile("s_waitcnt vmcnt(0)" : "+v"(v[0]), "+v"(v[1]), "+v"(v[2]), "+v"(v[3]), "+v"(v[4]), "+v"(v[5]), "+v"(v[6]), "+v"(v[7]) :: "memory"); }
__device__ __forceinline__ void gwait4(f32x4 (&v)[4]) { asm volatile("s_waitcnt vmcnt(0)" : "+v"(v[0]), "+v"(v[1]), "+v"(v[2]), "+v"(v[3]) :: "memory"); }
__device__ __forceinline__ void gwait8u(u32x2 (&v)[8]) { asm volatile("s_waitcnt vmcnt(0)" : "+v"(v[0]), "+v"(v[1]), "+v"(v[2]), "+v"(v[3]), "+v"(v[4]), "+v"(v[5]), "+v"(v[6]), "+v"(v[7]) :: "memory"); }
__device__ __forceinline__ void load_r8(const float* ssp, int row0, int fq, float (&r8)[2][4]) {
    f32x4 pv[8]; const float* p0 = ssp + ((size_t)fq * M + row0) * 4;
    gld16<0>(pv[0], p0); gld16<256>(pv[1], p0); gld16<512>(pv[2], p0); gld16<768>(pv[3], p0);
    gld16<2048>(pv[4], p0); gld16<2304>(pv[5], p0); gld16<2560>(pv[6], p0); gld16<2816>(pv[7], p0);
    gwait8(pv);
#pragma unroll
    for (int i = 0; i < 8; ++i) { float t = (pv[i][0] + pv[i][1]) + (pv[i][2] + pv[i][3]); t += __shfl_xor(t, 16); t += __shfl_xor(t, 32); r8[i >> 2][i & 3] = rs_of(t); }
}
__device__ __forceinline__ void load_r8_lds(const LAS float* ssl, int wr, int fr, int fq, float (&r8)[2][4]) {
#pragma unroll
    for (int i = 0; i < 8; ++i) { const f32x4 v = *(const LAS f32x4*)(ssl + (fq * 256 + (i >> 2) * 128 + wr * 64 + (i & 3) * 16 + fr) * 4);
        float t = (v[0] + v[1]) + (v[2] + v[3]); t += __shfl_xor(t, 16); t += __shfl_xor(t, 32); r8[i >> 2][i & 3] = rs_of(t); }
}
namespace pg8 {
constexpr int BM = 256, BK = 64, HALF = 128, HTB = HALF * BK * 2, STAGE_BYTES = 8 * HTB, NXCD = 8, WGM = 8;
__host__ __device__ __forceinline__ int lds_byte(int r, int c) { const int st = (r >> 4) * 2 + (c >> 5), rr = r & 15, cc = c & 31, ob = rr * 64 + cc * 2; return st * 1024 + (ob ^ (((ob >> 9) & 1) << 5)); }
__host__ __device__ __forceinline__ void stage_rc(int b, int& R, int& C) { const int st = b / 1024, sb = b % 1024, swz = sb ^ (((sb >> 9) & 1) << 5); R = (st >> 1) * 16 + swz / 64; C = (st & 1) * 32 + (swz % 64) / 2; }
__host__ __device__ __forceinline__ int perm32(int rho) { const int n = rho >> 4, i = rho & 15; return 8 * (i >> 2) + 4 * n + (i & 3); }
struct Unit { int pm, pn; };
struct Gemm { const bf16_t* A; const bf16_t* Bt; int M, N, K, lda, apn; };
struct StaticOrder {
    int nM, nN, nwg, G, c;
    __device__ void init(int M_, int N_, int G_, int c_) { nM = M_ / BM; nN = N_ / BM; nwg = nM * nN; G = G_; c = c_; }
    __device__ bool next(int i, Unit& u) const {
        const long L = (long)i * G + c; if (L >= nwg) return false;
        int wgid = (int)L; { const int q = nwg / NXCD, r = nwg % NXCD, xcd = wgid % NXCD, off = wgid / NXCD; wgid = (xcd < r ? xcd * (q + 1) : r * (q + 1) + (xcd - r) * q) + off; }
        const int nig = WGM * nN, gid = wgid / nig, fm = gid * WGM, gsz = (nM - fm) < WGM ? (nM - fm) : WGM;
        u.pm = fm + ((wgid % nig) % gsz); u.pn = (wgid % nig) / gsz; return true;
    }
};
template <class Epi, bool PG8_ALIGN_EPI>
__device__ __forceinline__ void gemm_phase(LAS unsigned char* lds, const Gemm g, const StaticOrder& S, const Epi& E) {
    const int tid = opaque_tid(), wid = __builtin_amdgcn_readfirstlane(tid >> 6), lane = tid & 63, wr = wid >> 2, wc = wid & 3, fr = lane & 15, fq = lane >> 4;
    const int K = g.K, nt = K / BK;
    unsigned voffA[2], voffB[2];
#pragma unroll
    for (int i = 0; i < 2; ++i) { int R, C; stage_rc(tid * 16 + i * 8192, R, C); const int Rb = (R & ~31) + perm32(R & 31);
        voffA[i] = (unsigned)(R * g.lda + C) * 2u; voffB[i] = (unsigned)(Rb * K + C) * 2u; }
    const size_t kstep = (size_t)(BK * 2);
    const size_t hstepA = (size_t)HALF * g.lda * 2, hstepB = (size_t)HALF * K * 2;
    const size_t tstepA = 2 * hstepA, tstepB = 2 * hstepB;
    const size_t apnb = (size_t)g.apn * 2;
    const unsigned ldsw = (unsigned)wid * 1024u;
    const int aoff = lds_byte(wr * 64 + fr, fq * 8), boff = lds_byte(wc * 32 + fr, fq * 8);
#define PG8_SA(b, h) (((b) * 2 + (h)) * HTB)
#define PG8_SB(b, h) ((4 + (b) * 2 + (h)) * HTB)
#define PG8_STAGE(bufoff, gbase, voff) do { _Pragma("unroll") for (int _i = 0; _i < 2; ++_i) \
        __builtin_amdgcn_global_load_lds((const unsigned*)((const char*)(gbase) + (voff)[_i]), (LAS unsigned*)(lds + (bufoff) + ldsw + _i * 8192), 16, 0, 0); } while (0)
#define PG8_LDA(dst, b, h) do { _Pragma("unroll") for (int m = 0; m < 4; ++m) _Pragma("unroll") for (int k = 0; k < 2; ++k) dst[m][k] = *(const LAS bf16x8*)(lds + PG8_SA(b, h) + aoff + m * 2048 + k * 1024); } while (0)
#define PG8_LDB(dst, b, h) do { _Pragma("unroll") for (int n = 0; n < 2; ++n) _Pragma("unroll") for (int k = 0; k < 2; ++k) dst[n][k] = *(const LAS bf16x8*)(lds + PG8_SB(b, h) + boff + n * 2048 + k * 1024); } while (0)
#define PG8_MMA(ai, bj, At, Bt) do { __builtin_amdgcn_s_setprio(1); _Pragma("unroll") for (int m = 0; m < 4; ++m) _Pragma("unroll") for (int n = 0; n < 2; ++n) _Pragma("unroll") for (int k = 0; k < 2; ++k) \
        acc[ai][bj][m][n] = __builtin_amdgcn_mfma_f32_16x16x32_bf16(Bt[n][k], At[m][k], acc[ai][bj][m][n], 0, 0, 0); __builtin_amdgcn_s_setprio(0); } while (0)
#define PG8_WAIT_V(n) asm volatile("s_waitcnt vmcnt(" #n ")" ::: "memory")
#define PG8_WAIT_L(n) asm volatile("s_waitcnt lgkmcnt(" #n ")" ::: "memory")
#define PG8_BAR __builtin_amdgcn_s_barrier()
#define PG8_SCHED __builtin_amdgcn_sched_barrier(0)
    Unit cur, nxt; int ui = 0;
    if (!S.next(0, cur)) return;
    f32x4 acc[2][2][4][2];
#pragma unroll
    for (int a = 0; a < 2; ++a)
#pragma unroll
        for (int b = 0; b < 2; ++b)
#pragma unroll
            for (int m = 0; m < 4; ++m)
#pragma unroll
                for (int n = 0; n < 2; ++n) acc[a][b][m][n] = (f32x4){0.f, 0.f, 0.f, 0.f};
    bf16x8 At[4][2], B0[2][2], B1[2][2];
    const char* cA = (const char*)g.A + (size_t)cur.pm * tstepA + (size_t)cur.pn * apnb; const char* cB = (const char*)g.Bt + (size_t)cur.pn * tstepB;
    PG8_STAGE(PG8_SB(0, 0), cB, voffB); PG8_STAGE(PG8_SB(0, 1), cB + hstepB, voffB); PG8_STAGE(PG8_SA(0, 0), cA, voffA); PG8_STAGE(PG8_SA(0, 1), cA + hstepA, voffA);
    if (wr == 1) PG8_BAR;
    PG8_WAIT_V(2); PG8_BAR;
    PG8_STAGE(PG8_SB(1, 0), cB + kstep, voffB); PG8_STAGE(PG8_SA(1, 0), cA + kstep, voffA); PG8_STAGE(PG8_SB(1, 1), cB + hstepB + kstep, voffB);
    PG8_WAIT_V(6); PG8_BAR;
#define PG8_SSDMA(u_) do { if constexpr (Epi::HAS_SS) { int ln_ = lane; asm volatile("" : "+v"(ln_)); const int pn_ = wid >> 1; \
        _Pragma("unroll") for (int jj_ = 0; jj_ < 2; ++jj_) { const int j_ = 2 * (wid & 1) + jj_; \
            __builtin_amdgcn_global_load_lds((const unsigned*)(E.ss + ((size_t)pn_ * M + 256 * (u_).pm + 64 * j_ + ln_) * 4), (LAS unsigned*)(lds + LDS_MAIN + (pn_ * 256 + 64 * j_) * 16), 16, 0, 0); } \
        if (wid < Epi::NAUX) __builtin_amdgcn_global_load_lds((const unsigned*)E.aux(wid, (u_), ln_), (LAS unsigned*)(lds + LDS_MAIN + 16384 + wid * 1024), 16, 0, 0); } } while (0)
    PG8_SSDMA(cur);
    for (;;) {
        const bool has_next = S.next(ui + 1, nxt);
        const char* nA = has_next ? (const char*)g.A + (size_t)nxt.pm * tstepA + (size_t)nxt.pn * apnb : cA; const char* nB = has_next ? (const char*)g.Bt + (size_t)nxt.pn * tstepB : cB;
        for (int t = 0; t < nt; t += 2) {
            const bool last = (t == nt - 2);
            const char* a1 = cA + (size_t)(t + 1) * kstep;
            const char* a2 = last ? nA : cA + (size_t)(t + 2) * kstep; const char* b2 = last ? nB : cB + (size_t)(t + 2) * kstep;
            const char* a3 = a2 + kstep; const char* b3 = b2 + kstep;
            PG8_LDB(B0, 0, 0); PG8_LDB(B1, 0, 1); PG8_SCHED; PG8_LDA(At, 0, 0); PG8_STAGE(PG8_SA(1, 1), a1 + hstepA, voffA);
            PG8_WAIT_V(8); PG8_WAIT_L(0); PG8_BAR;
            PG8_MMA(0, 0, At, B0); PG8_MMA(0, 1, At, B1); PG8_BAR; PG8_SCHED;
            PG8_LDA(At, 0, 1); PG8_STAGE(PG8_SB(0, 0), b2, voffB); PG8_STAGE(PG8_SB(0, 1), b2 + hstepB, voffB); PG8_STAGE(PG8_SA(0, 0), a2, voffA);
            PG8_WAIT_V(8); PG8_WAIT_L(0); PG8_BAR; PG8_MMA(1, 0, At, B0); PG8_MMA(1, 1, At, B1); PG8_BAR; PG8_SCHED;
            PG8_LDB(B0, 1, 0); PG8_LDB(B1, 1, 1); PG8_SCHED; PG8_LDA(At, 1, 0); PG8_STAGE(PG8_SA(0, 1), a2 + hstepA, voffA);
            PG8_WAIT_V(8); PG8_WAIT_L(0); PG8_BAR; PG8_MMA(0, 0, At, B0); PG8_MMA(0, 1, At, B1); PG8_BAR; PG8_SCHED;
            PG8_LDA(At, 1, 1); PG8_STAGE(PG8_SB(1, 0), b3, voffB); PG8_STAGE(PG8_SB(1, 1), b3 + hstepB, voffB); PG8_STAGE(PG8_SA(1, 0), a3, voffA);
            PG8_WAIT_V(8); PG8_WAIT_L(0); PG8_BAR; PG8_MMA(1, 0, At, B0); PG8_MMA(1, 1, At, B1); PG8_BAR; PG8_SCHED;
        }
        if (PG8_ALIGN_EPI) { if (wr == 0) PG8_BAR; }
        { int fr_e = fr, fq_e = fq; asm volatile("" : "+v"(fr_e), "+v"(fq_e));
          E(acc, cur, wr, wc, fr_e, fq_e); }
        if (!has_next) break;
#pragma unroll
        for (int a = 0; a < 2; ++a)
#pragma unroll
            for (int b = 0; b < 2; ++b)
#pragma unroll
                for (int m = 0; m < 4; ++m)
#pragma unroll
                    for (int n = 0; n < 2; ++n) acc[a][b][m][n] = (f32x4){0.f, 0.f, 0.f, 0.f};
        cur = nxt; cA = nA; cB = nB; ++ui;
        if constexpr (Epi::HAS_SS) { PG8_BAR; PG8_SSDMA(cur); }
        if (PG8_ALIGN_EPI) { if (wr == 1) PG8_BAR; }
    }
    PG8_WAIT_V(0);
    if (!PG8_ALIGN_EPI) { if (wr == 0) PG8_BAR; }
    PG8_BAR;
#undef PG8_SA
#undef PG8_SB
#undef PG8_STAGE
#undef PG8_LDA
#undef PG8_LDB
#undef PG8_MMA
#undef PG8_WAIT_V
#undef PG8_WAIT_L
#undef PG8_BAR
#undef PG8_SCHED
#undef PG8_SSDMA
}
}
using pg8::Unit;

typedef const f32x4 (&AccRef)[2][2][4][2];
__device__ __forceinline__ u32x4 pack8(f32x4 a, f32x4 b) { u32x4 w; w.x = pk_bf16(a[0], a[1]); w.y = pk_bf16(a[2], a[3]); w.z = pk_bf16(b[0], b[1]); w.w = pk_bf16(b[2], b[3]); return w; }

struct EpiSwiglu {      static constexpr bool HAS_SS = true; static constexpr int NAUX = 1;
    bf16_t* O; const float* ss; const float* bias; const LAS float* ssl;
    __device__ __forceinline__ const float* aux(int, const Unit& u, int lane) const { return bias + (size_t)(u.pm >> 5) * (2 * DFF) + u.pn * 256 + 4 * lane; }
    __device__ __forceinline__ void operator()(AccRef acc, const Unit& u, int wr, int wc, int fr, int fq) const {
        const int row0 = u.pm * 256 + wr * 64 + fr, col0 = u.pn * 128 + wc * 32 + 8 * fq;
        const LAS float* bl = ssl + 4096 + wc * 32 + 8 * fq;
        const f32x4 bg[2] = {*(const LAS f32x4*)bl, *(const LAS f32x4*)(bl + 4)}, bu[2] = {*(const LAS f32x4*)(bl + 128), *(const LAS f32x4*)(bl + 132)};
        float r8[2][4]; load_r8_lds(ssl, wr, fr, fq, r8);
#pragma unroll
        for (int ai = 0; ai < 2; ++ai)
#pragma unroll
            for (int m = 0; m < 4; ++m) {
                const int row = row0 + ai * 128 + m * 16; const float r = r8[ai][m];
                f32x4 h[2];
#pragma unroll
                for (int n = 0; n < 2; ++n) { const f32x4 gg = acc[ai][0][m][n] * r + bg[n], uu = acc[ai][1][m][n] * r + bu[n];
#pragma unroll
                    for (int j = 0; j < 4; ++j) h[n][j] = silu_f(gg[j]) * uu[j]; }
                *(u32x4*)(O + (size_t)row * DFF + col0) = pack8(h[0], h[1]);
            }
    }
};

template <bool GLU> struct EpiRes {         static constexpr bool HAS_SS = false; static constexpr int NAUX = 0; static constexpr int RB = GLU ? 2 : 4;
    const _Float16* baseh; float* out32; _Float16* outh;
    const float* gate; const float* colscale; const bf16_t* glu; const float* gsn; float* ssn; bf16_t* xs; float coef; int pad;
    __device__ __forceinline__ void operator()(f32x4 (&acc)[2][2][4][2], const Unit& u, int wr, int wc, int fr, int fq) const {
        typedef _Float16 h16x8 __attribute__((ext_vector_type(8)));
        const int row0 = u.pm * 256 + wr * 64 + fr, col0 = u.pn * 256 + wc * 32 + 8 * fq;
        const float* gv = gate + (size_t)(u.pm >> 5) * NMOD;
        const float* gsb = gsn ? gsn + (size_t)(u.pm >> 5) * D : nullptr;
        f32x4 gm[2][2], gsv[2][2];
        { f32x4 gq[8];
          const float* gp0 = gv + col0; const float* gp1 = (gsb ? gsb : gv) + col0;
          gld16<0>(gq[0], gp0); gld16<16>(gq[1], gp0); gld16<512>(gq[2], gp0); gld16<528>(gq[3], gp0);
          gld16<0>(gq[4], gp1); gld16<16>(gq[5], gp1); gld16<512>(gq[6], gp1); gld16<528>(gq[7], gp1); gwait8(gq);
#pragma unroll
          for (int bj = 0; bj < 2; ++bj)
#pragma unroll
            for (int n = 0; n < 2; ++n) { const int c = col0 + bj * 128 + 4 * n; f32x4 t = (gq[bj * 2 + n] + 1.0f) * coef;
                if (colscale) t = t * *(const f32x4*)(colscale + c); gm[bj][n] = t; gsv[bj][n] = gq[4 + bj * 2 + n]; } }
#pragma unroll
        for (int ai = 0; ai < 2; ++ai)
#pragma unroll
          for (int mp = 0; mp < 4 / RB; ++mp) {
            if constexpr (GLU) {
                f32x4 gq8[4];
#pragma unroll
                for (int mm = 0; mm < 2; ++mm) { const bf16_t* pg = glu + (size_t)(row0 + ai * 128 + (2 * mp + mm) * 16) * D + col0; gld16<0>(gq8[mm * 2], pg); gld16<256>(gq8[mm * 2 + 1], pg); }
                gwait4(gq8);
#pragma unroll
                for (int mm = 0; mm < 2; ++mm)
#pragma unroll
                    for (int bj = 0; bj < 2; ++bj) { const u32x4 gw4 = __builtin_bit_cast(u32x4, gq8[mm * 2 + bj]); const int m = 2 * mp + mm;
#pragma unroll
                        for (int n = 0; n < 2; ++n) { const unsigned w0 = n ? gw4.z : gw4.x, w1 = n ? gw4.w : gw4.y; const f32x4 gg = {bf_lo(w0), bf_hi(w0), bf_lo(w1), bf_hi(w1)};
#pragma unroll
                            for (int j = 0; j < 4; ++j) acc[ai][bj][m][n][j] = gg[j] * fast_sigmoid(acc[ai][bj][m][n][j]); } }
            }
            f32x4 hq[2 * RB];
#pragma unroll
            for (int mm = 0; mm < RB; ++mm) { const _Float16* pb = baseh + (size_t)(row0 + ai * 128 + (RB * mp + mm) * 16) * D + col0; gld16<0>(hq[mm * 2], pb); gld16<256>(hq[mm * 2 + 1], pb); }
            if constexpr (RB == 2) gwait4(hq); else gwait8(hq);
#pragma unroll
            for (int mm = 0; mm < RB; ++mm) { const int m = RB * mp + mm; const int row = row0 + ai * 128 + m * 16; const size_t ro = (size_t)row * D;
                float sq = 0.f;
#pragma unroll
                for (int bj = 0; bj < 2; ++bj) { f32x4 o[2];
                    const h16x8 hb8 = __builtin_bit_cast(h16x8, hq[mm * 2 + bj]);
#pragma unroll
                    for (int n = 0; n < 2; ++n) { const f32x4 bs = {(float)hb8[4 * n], (float)hb8[4 * n + 1], (float)hb8[4 * n + 2], (float)hb8[4 * n + 3]};
                        o[n] = bs + gm[bj][n] * acc[ai][bj][m][n];
                        sq += (o[n][0] * o[n][0] + o[n][1] * o[n][1]) + (o[n][2] * o[n][2] + o[n][3] * o[n][3]); }
                    const int c = col0 + bj * 128;
                    if (out32) { *(f32x4*)(out32 + ro + c) = o[0]; *(f32x4*)(out32 + ro + c + 4) = o[1]; }
                    else { const u32x2 h0 = __builtin_bit_cast(u32x2, __builtin_convertvector(o[0], h16x4)), h1 = __builtin_bit_cast(u32x2, __builtin_convertvector(o[1], h16x4));
                        u32x4 w; w.x = h0.x; w.y = h0.y; w.z = h1.x; w.w = h1.y; *(u32x4*)(outh + ro + c) = w; }
                    if (gsb) *(u32x4*)(xs + ro + c) = pack8(o[0] * gsv[bj][0], o[1] * gsv[bj][1]); }
                if (gsb) { sq += __shfl_xor(sq, 16); sq += __shfl_xor(sq, 32); if (fq == 0) ssn[((size_t)u.pn * M + row) * 4 + wc] = sq; } }
            asm volatile("" ::: "memory"); }
    }
};

struct EpiQKV {         static constexpr bool HAS_SS = true; static constexpr int NAUX = 2;
    bf16_t *Qo; float* logf; const float *qg, *kg, *bfv; const float* ss; const float* bias; const LAS float* ssl;
    __device__ __forceinline__ const float* aux(int k, const Unit& u, int lane) const {
        return k == 0 ? bias + (size_t)(u.pm >> 5) * NFOX + u.pn * 256 + 4 * lane : (lane < 16 ? qg + 4 * lane : kg + 4 * (lane & 15)); }
    __device__ __forceinline__ void operator()(AccRef acc, const Unit& u, int wr, int wc, int fr, int fq) const {
        const int row0 = u.pm * 256 + wr * 64 + fr;
        float r8[2][4]; load_r8_lds(ssl, wr, fr, fq, r8);
        f32x4 bgv[8];
        { const LAS float* bl = ssl + 4096 + wc * 32 + 8 * fq; const LAS float* gl = ssl + 4096 + 256 + (u.pn < 4 ? 0 : 64) + 8 * fq;
          bgv[0] = *(const LAS f32x4*)bl; bgv[1] = *(const LAS f32x4*)(bl + 4); bgv[2] = *(const LAS f32x4*)(bl + 128); bgv[3] = *(const LAS f32x4*)(bl + 132);
          bgv[4] = *(const LAS f32x4*)gl; bgv[5] = *(const LAS f32x4*)(gl + 4); bgv[6] = *(const LAS f32x4*)(gl + 32); bgv[7] = *(const LAS f32x4*)(gl + 36); }
        if (u.pn < 12) {
            const int which = u.pn >> 2, head = 4 * (u.pn & 3) + wc;
            bf16_t* dst = Qo + (size_t)which * ((WS_R3 - WS_R2) / 2);
            const float gs = which == 0 ? QSCALE : 1.0f;
#pragma unroll
            for (int ai = 0; ai < 2; ++ai)
#pragma unroll
                for (int m = 0; m < 4; ++m) {
                    const int row = row0 + ai * 128 + m * 16; const float r = r8[ai][m];
                    f32x4 v[2][2];
#pragma unroll
                    for (int bj = 0; bj < 2; ++bj)
#pragma unroll
                        for (int n = 0; n < 2; ++n) v[bj][n] = acc[ai][bj][m][n] * r + bgv[bj * 2 + n];
                    float rinv = 1.0f;
                    if (which < 2) { float sq = 0.f;
#pragma unroll
                        for (int bj = 0; bj < 2; ++bj)
#pragma unroll
                            for (int n = 0; n < 2; ++n) { const f32x4 a = v[bj][n]; sq += (a[0] * a[0] + a[1] * a[1]) + (a[2] * a[2] + a[3] * a[3]); }
                        sq += __shfl_xor(sq, 16); sq += __shfl_xor(sq, 32);
                        rinv = rsqrtf(sq * (1.0f / 64.0f) + EPS) * gs; }
                    bf16_t* rp = dst + (size_t)row * D + head * 64 + 8 * fq;
#pragma unroll
                    for (int bj = 0; bj < 2; ++bj) {
                        f32x4 g0 = {1.f, 1.f, 1.f, 1.f}, g1 = g0;
                        if (which < 2) { g0 = bgv[4 + bj * 2]; g1 = bgv[5 + bj * 2]; }
                        *(u32x4*)(rp + 32 * bj) = pack8(v[bj][0] * rinv * g0, v[bj][1] * rinv * g1); }
                    asm volatile("" ::: "memory");
                }
        } else if (wc == 0 && fq < 2) {
#pragma unroll
            for (int ai = 0; ai < 2; ++ai)
#pragma unroll
                for (int m = 0; m < 4; ++m) { const int row = row0 + ai * 128 + m * 16; const float r = r8[ai][m];
#pragma unroll
                    for (int n = 0; n < 2; ++n) { const f32x4 bb = *(const f32x4*)(bfv + 8 * fq + 4 * n) + bgv[n]; f32x4 v = acc[ai][0][m][n] * r + bb;
#pragma unroll
                        for (int j = 0; j < 4; ++j) v[j] = log_sigmoid(v[j]);
                        *(f32x4*)(logf + (size_t)row * 16 + 8 * fq + 4 * n) = v; } }
        }
    }
};

struct EpiConvIn {      static constexpr bool HAS_SS = true; static constexpr int NAUX = 1;
    bf16_t *CZ, *BG; const float* ss; const float* bias; const LAS float* ssl;
    __device__ __forceinline__ const float* aux(int, const Unit& u, int lane) const { return bias + (size_t)(u.pm >> 5) * (3 * D) + u.pn * 256 + 4 * lane; }
    __device__ __forceinline__ void operator()(AccRef acc, const Unit& u, int wr, int wc, int fr, int fq) const {
        const int row0 = u.pm * 256 + wr * 64 + fr;
        const LAS float* bl = ssl + 4096 + wc * 32 + 8 * fq;
        const f32x4 bv[2][2] = {{*(const LAS f32x4*)bl, *(const LAS f32x4*)(bl + 4)}, {*(const LAS f32x4*)(bl + 128), *(const LAS f32x4*)(bl + 132)}};
        float r8[2][4]; load_r8_lds(ssl, wr, fr, fq, r8);
        if (u.pn < 8) {
#pragma unroll
            for (int ai = 0; ai < 2; ++ai)
#pragma unroll
                for (int m = 0; m < 4; ++m) { const int row = row0 + ai * 128 + m * 16; const float r = r8[ai][m];
                    *(u32x4*)(CZ + (size_t)row * D + u.pn * 128 + wc * 32 + 8 * fq) = pack8((acc[ai][0][m][0] * r + bv[0][0]) * (acc[ai][1][m][0] * r + bv[1][0]), (acc[ai][0][m][1] * r + bv[0][1]) * (acc[ai][1][m][1] * r + bv[1][1])); }
        } else {
#pragma unroll
            for (int ai = 0; ai < 2; ++ai)
#pragma unroll
                for (int m = 0; m < 4; ++m) { const int row = row0 + ai * 128 + m * 16; const float r = r8[ai][m];
#pragma unroll
                    for (int bj = 0; bj < 2; ++bj)
                        *(u32x4*)(BG + (size_t)row * D + (u.pn - 8) * 256 + bj * 128 + wc * 32 + 8 * fq) = pack8(acc[ai][bj][m][0] * r + bv[bj][0], acc[ai][bj][m][1] * r + bv[bj][1]); }
        }
    }
};

__device__ __forceinline__ int colmap(int type, int r) {
    const int pn = r >> 8, c = r & 255;
    if (type == 1) return (c >> 7) * DFF + pn * 128 + (c & 127);
    if (type == 2) return r < 3072 ? pn * 256 + ((c >> 5) & 3) * 64 + (c >> 7) * 32 + (c & 31) : r;
    if (type == 3) return pn < 8 ? 1024 + (c >> 7) * 1024 + pn * 128 + (c & 127) : (pn - 8) * 256 + c;
    return r;
}
__device__ __forceinline__ void transpose_item(const float* W, int ld, int K, bf16_t* WT, int type, int nvalid, LAS float* scr, int kb, int nb, int lane) {
    const int k0 = 64 * kb, n0 = 32 * nb; const int sc = colmap(type, n0) + (lane & 31); const bool ok = sc < nvalid;
    float wv[32];
#pragma unroll
    for (int i = 0; i < 32; ++i) { const int kk = 2 * i + (lane >> 5); wv[i] = ok ? W[(size_t)(k0 + kk) * ld + sc] : 0.f; }
#pragma unroll
    for (int i = 0; i < 32; ++i) { const int kk = 2 * i + (lane >> 5); scr[kk * 33 + (lane & 31)] = wv[i]; }
    asm volatile("s_waitcnt lgkmcnt(0)" ::: "memory");
    const int c = lane & 7;
#pragma unroll
    for (int j = 0; j < 4; ++j) { const int n = (lane >> 3) + 8 * j; const LAS float* s = scr + (8 * c) * 33 + n;
        u32x4 o; o.x = pk_bf16(s[0 * 33], s[1 * 33]); o.y = pk_bf16(s[2 * 33], s[3 * 33]); o.z = pk_bf16(s[4 * 33], s[5 * 33]); o.w = pk_bf16(s[6 * 33], s[7 * 33]);
        *(u32x4*)(WT + (size_t)(n0 + n) * K + k0 + 8 * c) = o; }
    asm volatile("s_waitcnt lgkmcnt(0)" ::: "memory");
}

__device__ __forceinline__ void prologue_phase(KP kp, LAS unsigned char* lds, int rep) {
    const int tid = opaque_tid(), lane = tid & 63, wid = tid >> 6, G = gridDim.x;
    unsigned char* ws = kp->ws;
    {
        LAS float* condS = (LAS float*)lds; LAS float* red = (LAS float*)(lds + 16384);
        const float* cin = kp->in[1];
        for (int i = tid; i < 4096; i += NTHREADS) condS[i] = silu_f(cin[i]);
        __syncthreads();
        float* mod = (float*)(ws + WS_MOD);
        const float* ada_w = kp->in[2]; const float* ada_b = kp->in[3];
        for (int it = blockIdx.x; it < 288; it += G) {
            const int l = it / 72, col0 = (it % 72) * 128, cq = tid & 31, kc = tid >> 5;
            f32x4 a0 = {0, 0, 0, 0}, a1 = a0, a2 = a0, a3 = a0;
            const float* wp = ada_w + ((size_t)l * D + kc * 64) * NMOD + col0 + cq * 4;
#pragma unroll 16
            for (int i = 0; i < 64; ++i) { const f32x4 w = *(const f32x4*)(wp + (size_t)i * NMOD); const int k = kc * 64 + i;
                a0 += w * condS[k]; a1 += w * condS[1024 + k]; a2 += w * condS[2048 + k]; a3 += w * condS[3072 + k]; }
            *(LAS f32x4*)(red + (kc * 4 + 0) * 128 + cq * 4) = a0; *(LAS f32x4*)(red + (kc * 4 + 1) * 128 + cq * 4) = a1;
            *(LAS f32x4*)(red + (kc * 4 + 2) * 128 + cq * 4) = a2; *(LAS f32x4*)(red + (kc * 4 + 3) * 128 + cq * 4) = a3;
            __syncthreads();
            { const int b = tid >> 7, col = tid & 127; float s = ada_b[l * NMOD + col0 + col];
#pragma unroll
              for (int k2 = 0; k2 < 16; ++k2) s += red[(k2 * 4 + b) * 128 + col];
              mod[(size_t)(l * 4 + b) * NMOD + col0 + col] = s; }
            __syncthreads();
        }
    }
    __syncthreads();
    {
        LAS float* scr = (LAS float*)(lds + wid * 8448);
        constexpr int I_FIN = 16 * 176, I_FOUT = 44 * 32, I_FOXIN = 16 * 104, I_SQ = 16 * 32, I_CONVIN = 16 * 96, I_POOL = 4 * 8;
        constexpr int NITEMS = 8 * I_FIN + 8 * I_FOUT + I_FOXIN + 3 * I_SQ + I_CONVIN + I_SQ * 0 + 4 * I_POOL;
        unsigned* steal = (unsigned*)(ws + WS_BAR) + 3584 + 64 * rep;
        for (;;) {
        unsigned base8 = 0u; if (lane == 0) base8 = atomicAdd(steal, 8u);
        base8 = (unsigned)__builtin_amdgcn_readfirstlane((int)base8);
        if (base8 >= (unsigned)NITEMS) break;
        for (int it = (int)base8; it < (int)base8 + 8 && it < NITEMS; ++it) {
            int r = it; const float* src; bf16_t* dst; int K, ld, nd, type = 0, nvalid;
            if (r < 8 * I_FIN) { const int j = r / I_FIN; r %= I_FIN; src = kp->in[5] + (size_t)j * D * 2 * DFF; dst = (bf16_t*)(ws + WS_WFFIN) + (size_t)j * 2 * DFF * D; K = D; ld = 2 * DFF; nd = 2 * DFF; type = 1; nvalid = ld; }
            else if ((r -= 8 * I_FIN) < 8 * I_FOUT) { const int j = r / I_FOUT; r %= I_FOUT; src = kp->in[6] + (size_t)j * DFF * D; dst = (bf16_t*)(ws + WS_WFFOUT) + (size_t)j * D * DFF; K = DFF; ld = D; nd = D; nvalid = ld; }
            else if ((r -= 8 * I_FOUT) < I_FOXIN) { src = kp->in[9]; dst = (bf16_t*)(ws + WS_WFOXIN); K = D; ld = 3 * D + 16; nd = NFOX; type = 2; nvalid = ld; }
            else if ((r -= I_FOXIN) < I_SQ) { src = kp->in[13]; dst = (bf16_t*)(ws + WS_WFOXO); K = D; ld = D; nd = D; nvalid = ld; }
            else if ((r -= I_SQ) < I_SQ) { src = kp->in[22]; dst = (bf16_t*)(ws + WS_WGLU); K = D; ld = D; nd = D; nvalid = ld; }
            else if ((r -= I_SQ) < I_CONVIN) { src = kp->in[23]; dst = (bf16_t*)(ws + WS_WCONVIN); K = D; ld = 3 * D; nd = 3 * D; type = 3; nvalid = ld; }
            else if ((r -= I_CONVIN) < I_SQ) { src = kp->in[25]; dst = (bf16_t*)(ws + WS_WCONVOUT); K = D; ld = D; nd = D; nvalid = ld; }
            else { r -= I_SQ; const int j = r / I_POOL; r %= I_POOL; src = kp->in[7] + (size_t)j * 256 * 256; dst = (bf16_t*)(ws + WS_WPOOL) + (size_t)j * 256 * 256; K = 256; ld = 256; nd = 256; nvalid = ld; }
            const int nblk = nd / 32;
            transpose_item(src, ld, K, dst, type, nvalid, scr, r / nblk, r % nblk, lane);
        }
        }
    }
}

__device__ __forceinline__ void load8(const bf16_t* p, float (&f)[8]) { const u32x4 w = *(const u32x4*)p; f[0] = bf_lo(w.x); f[1] = bf_hi(w.x); f[2] = bf_lo(w.y); f[3] = bf_hi(w.y); f[4] = bf_lo(w.z); f[5] = bf_hi(w.z); f[6] = bf_lo(w.w); f[7] = bf_hi(w.w); }
__device__ __forceinline__ void store8(bf16_t* p, const float (&f)[8]) { u32x4 w; w.x = pk_bf16(f[0], f[1]); w.y = pk_bf16(f[2], f[3]); w.z = pk_bf16(f[4], f[5]); w.w = pk_bf16(f[6], f[7]); *(u32x4*)p = w; }
__device__ __forceinline__ void norm0_phase(KP kp) {
    const int tid = opaque_tid(), lane = tid & 63, wid = tid >> 6;
    const int gw = blockIdx.x * NWAVES + wid, NGW = gridDim.x * NWAVES;
    unsigned char* ws = kp->ws;
    const float* mod = (const float*)(ws + WS_MOD); const float* gain = kp->in[4]; const float* x = kp->in[0];
    bf16_t* xs = (bf16_t*)(ws + WS_HB); float* ss = (float*)(ws + WS_SS); _Float16* xh = (_Float16*)(ws + WS_XH);
    for (int row0 = gw; row0 < M; row0 += 2 * NGW) {
        const int rowB = (row0 + NGW < M) ? row0 + NGW : row0;
        f32x4 v[2][4]; float sq[2] = {0.f, 0.f};
#pragma unroll
        for (int q = 0; q < 2; ++q) { const f32x4* xr = (const f32x4*)(x + (size_t)(q ? rowB : row0) * D) + lane;
#pragma unroll
            for (int j = 0; j < 4; ++j) v[q][j] = xr[64 * j]; }
#pragma unroll
        for (int q = 0; q < 2; ++q) {
#pragma unroll
            for (int j = 0; j < 4; ++j) sq[q] += (v[q][j][0] * v[q][j][0] + v[q][j][1] * v[q][j][1]) + (v[q][j][2] * v[q][j][2] + v[q][j][3] * v[q][j][3]);
            sq[q] = wave_sum(sq[q]); }
#pragma unroll
        for (int q = 0; q < 2; ++q) { const int row = q ? rowB : row0; if (q && rowB == row0) break;
            const float* scale = mod + (size_t)(row >> 13) * NMOD + D;
            if (lane < 16) ss[((size_t)(lane >> 2) * M + row) * 4 + (lane & 3)] = lane == 0 ? sq[q] : 0.f;
            u32x2* o8 = (u32x2*)(xs + (size_t)row * D) + lane; u32x2* h8 = (u32x2*)(xh + (size_t)row * D) + lane;
#pragma unroll
            for (int j = 0; j < 4; ++j) { const int c = 4 * (lane + 64 * j);
                const f32x4 o = v[q][j] * *(const f32x4*)(gain + c) * (*(const f32x4*)(scale + c) + 1.0f);
                u32x2 w; w.x = pk_bf16(o[0], o[1]); w.y = pk_bf16(o[2], o[3]); o8[64 * j] = w;
                h8[64 * j] = __builtin_bit_cast(u32x2, __builtin_convertvector(v[q][j], h16x4)); } }
    }
    { float* gs = (float*)(ws + WS_GS);
      for (int i = blockIdx.x * NTHREADS + tid; i < 12 * 4 * D; i += gridDim.x * NTHREADS) { const int c = i & (D - 1), b = (i >> 10) & 3, sidx = i >> 12, l = sidx / 3, sub = sidx % 3;
          gs[i] = gain[sidx * D + c] * (1.0f + mod[(size_t)(l * 4 + b) * NMOD + (sub * 3 + 1) * D + c]); } }
    { float* bv = (float*)(ws + WS_BIASV);
      constexpr int R_FFN = 2 * DFF, R_ALL = 8 * R_FFN + NFOX + 3 * D;
      for (int rr0 = gw; rr0 < R_ALL; rr0 += 2 * NGW) {
          const bf16_t* wrow[2]; const float* sh[2]; float* dst[2]; int nstr[2]; float w[2][16];
#pragma unroll
          for (int q = 0; q < 2; ++q) { const int rr = (q && rr0 + NGW < R_ALL) ? rr0 + NGW : rr0;
              if (rr < 8 * R_FFN) { const int j = rr / R_FFN, n = rr % R_FFN, l = j >> 1, sub = (j & 1) ? 2 : 0;
                  wrow[q] = (const bf16_t*)(ws + WS_WFFIN) + ((size_t)j * R_FFN + n) * D; sh[q] = mod + (size_t)l * 4 * NMOD + (sub * 3) * D; dst[q] = bv + (size_t)j * BV_FFN + n; nstr[q] = R_FFN; }
              else if (rr < 8 * R_FFN + NFOX) { const int n = rr - 8 * R_FFN; wrow[q] = (const bf16_t*)(ws + WS_WFOXIN) + (size_t)n * D; sh[q] = mod + (size_t)1 * 4 * NMOD + 3 * D; dst[q] = bv + BV_QKV_OFF + n; nstr[q] = NFOX; }
              else { const int n = rr - 8 * R_FFN - NFOX; wrow[q] = (const bf16_t*)(ws + WS_WCONVIN) + (size_t)n * D; sh[q] = mod + (size_t)3 * 4 * NMOD + 3 * D; dst[q] = bv + BV_CONV_OFF + n; nstr[q] = 3 * D; }
              float f[8]; load8(wrow[q] + 16 * lane, f);
#pragma unroll
              for (int j = 0; j < 8; ++j) w[q][j] = f[j];
              load8(wrow[q] + 16 * lane + 8, f);
#pragma unroll
              for (int j = 0; j < 8; ++j) w[q][8 + j] = f[j]; }
#pragma unroll
          for (int q = 0; q < 2; ++q) { if (q && rr0 + NGW >= R_ALL) break;
#pragma unroll
              for (int b = 0; b < 4; ++b) { const float* sp = sh[q] + (size_t)b * NMOD + 16 * lane; float a = 0.f;
#pragma unroll
                  for (int q4 = 0; q4 < 4; ++q4) { const f32x4 sv = *(const f32x4*)(sp + 4 * q4); a += (w[q][4 * q4] * sv[0] + w[q][4 * q4 + 1] * sv[1]) + (w[q][4 * q4 + 2] * sv[2] + w[q][4 * q4 + 3] * sv[3]); }
                  a = wave_sum(a); if (lane == 0) dst[q][(size_t)b * nstr[q]] = a; } }
      } }
}

__device__ __forceinline__ void load8n(const bf16_t* p, const float* ssp, int row, const float (&sh)[8], float (&f)[8]) { load8(p, f); const float r = rs_row(ssp, row);
#pragma unroll
    for (int j = 0; j < 8; ++j) f[j] = f[j] * r + sh[j]; }
__device__ __forceinline__ void pool_phase(const bf16_t* xs, const float* ss, const float* shiftl, bf16_t* pooled) {
    const int tid = opaque_tid();
    for (int wi = blockIdx.x; wi < 512; wi += gridDim.x) {
        const int rb = wi * 4 + (tid >> 7), o = tid & 127, w = 2 << (o >> 5);
        const int row0 = rb * 16, t0 = row0 & (SEQ - 1);
        const bf16_t* hp = xs + (size_t)row0 * D + o * 8;
        float sh[8]; { const float* shp = shiftl + (size_t)(row0 >> 13) * NMOD + o * 8;
#pragma unroll
            for (int j = 0; j < 8; ++j) sh[j] = shp[j]; }
        float sum[8], cur[8], old[8];
#pragma unroll
        for (int j = 0; j < 8; ++j) sum[j] = 0.f;
        for (int k = 1; k < w; ++k) if (t0 - k >= 0) { load8n(hp - (size_t)k * D, ss, row0 - k, sh, old);
#pragma unroll
            for (int j = 0; j < 8; ++j) sum[j] += old[j]; }
        for (int tt = 0; tt < 16; ++tt) {
            const int t = t0 + tt; load8n(hp + (size_t)tt * D, ss, row0 + tt, sh, cur);
            const float inv = 1.0f / (float)((t + 1) < w ? (t + 1) : w);
            float ov[8];
#pragma unroll
            for (int j = 0; j < 8; ++j) { sum[j] += cur[j]; ov[j] = sum[j] * inv - cur[j]; }
            store8(pooled + (size_t)(row0 + tt) * D + o * 8, ov);
            if (t - w + 1 >= 0) { load8n(hp + (size_t)(tt - w + 1) * D, ss, row0 + tt - w + 1, sh, old);
#pragma unroll
                for (int j = 0; j < 8; ++j) sum[j] -= old[j]; }
        }
    }
}

__device__ __forceinline__ void conv_phase(const bf16_t* cz, const bf16_t* bg, const float* cw, bf16_t* a2) {
    const int tid = opaque_tid(), o = tid & 127;
    float w0[8], w1[8], w2[8];
#pragma unroll
    for (int j = 0; j < 8; ++j) { w0[j] = cw[o * 8 + j]; w1[j] = cw[D + o * 8 + j]; w2[j] = cw[2 * D + o * 8 + j]; }
    for (int wi = blockIdx.x; wi < M / 4; wi += gridDim.x) {
        const int row = wi * 4 + (tid >> 7), t = row & (SEQ - 1);
        const size_t off = (size_t)row * D + o * 8;
        float x0[8], x1[8], x2[8], b[8], ov[8];
        load8(cz + off, x2); load8(bg + off, b);
        if (t >= 1) load8(cz + off - D, x1); else {
#pragma unroll
            for (int j = 0; j < 8; ++j) x1[j] = 0.f; }
        if (t >= 2) load8(cz + off - 2 * D, x0); else {
#pragma unroll
            for (int j = 0; j < 8; ++j) x0[j] = 0.f; }
#pragma unroll
        for (int j = 0; j < 8; ++j) ov[j] = b[j] * (w0[j] * x0[j] + w1[j] * x1[j] + w2[j] * x2[j]);
        store8(a2 + off, ov);
    }
}

__device__ __forceinline__ void cumsum_phase(const float* logf, float* biasK, LAS unsigned char* lds) {
    const int tid = opaque_tid(), lane = tid & 63, wid = tid >> 6;
    LAS float* wtot = (LAS float*)lds;
    for (int it = blockIdx.x; it < 64; it += gridDim.x) {
        const int b = it >> 4, h = it & 15;
        const size_t base = ((size_t)b * SEQ + tid * 16) * 16 + h;
        float v[16];
#pragma unroll
        for (int i = 0; i < 16; ++i) v[i] = logf[base + (size_t)i * 16];
#pragma unroll
        for (int i = 1; i < 16; ++i) v[i] += v[i - 1];
        float inc = v[15];
#pragma unroll
        for (int o = 1; o < 64; o <<= 1) { const float t = __shfl_up(inc, o); if (lane >= o) inc += t; }
        if (lane == 63) wtot[wid] = inc;
        __syncthreads();
        float off = inc - v[15];
        for (int w2 = 0; w2 < wid; ++w2) off += wtot[w2];
#pragma unroll
        for (int i = 0; i < 16; ++i) biasK[base + (size_t)i * 16] = -LOG2E * (v[i] + off);
        __syncthreads();
    }
}

__device__ __forceinline__ int crow(int r, int hi) { return (r & 3) + 8 * (r >> 2) + 4 * hi; }
__device__ __forceinline__ void att_tile(const LAS unsigned char* bb, const bf16x8 (&qr)[4], int t, int wq0, int qloc, int r32, int hi, float& mrun, float& lrun, f32x16 (&oT)[2]) {
    constexpr int ROWB = 144, KT = 64 * ROWB;
    const LAS float* bias = (const LAS float*)(bb + 2 * KT);
    f32x16 p0, p1;
#pragma unroll
    for (int g4 = 0; g4 < 4; ++g4) { const f32x4 b0 = *(const LAS f32x4*)(bias + 8 * g4 + 4 * hi), b1 = *(const LAS f32x4*)(bias + 32 + 8 * g4 + 4 * hi);
#pragma unroll
        for (int j = 0; j < 4; ++j) { p0[4 * g4 + j] = b0[j]; p1[4 * g4 + j] = b1[j]; } }
#pragma unroll
    for (int d0 = 0; d0 < 4; ++d0) {
        const bf16x8 k0 = *(const LAS bf16x8*)(bb + r32 * ROWB + d0 * 32 + hi * 16);
        const bf16x8 k1 = *(const LAS bf16x8*)(bb + (32 + r32) * ROWB + d0 * 32 + hi * 16);
        p0 = __builtin_amdgcn_mfma_f32_32x32x16_bf16(k0, qr[d0], p0, 0, 0, 0);
        p1 = __builtin_amdgcn_mfma_f32_32x32x16_bf16(k1, qr[d0], p1, 0, 0, 0);
    }
    if (64 * t + 63 > wq0) {
#pragma unroll
        for (int r = 0; r < 16; ++r) { const int kv = 64 * t + crow(r, hi); if (kv > qloc) p0[r] = -1e30f; if (kv + 32 > qloc) p1[r] = -1e30f; }
    }
    float mt = fmaxf(p0[0], p1[0]);
#pragma unroll
    for (int r = 1; r < 16; ++r) mt = fmaxf(mt, fmaxf(p0[r], p1[r]));
    mt = fmaxf(mt, __shfl_xor(mt, 32));
    const float mnew = fmaxf(mrun, mt);
    const float alpha = __builtin_amdgcn_exp2f(mrun - mnew);
    mrun = mnew;
    float ls = 0.f;
#pragma unroll
    for (int r = 0; r < 16; ++r) { p0[r] = __builtin_amdgcn_exp2f(p0[r] - mnew); p1[r] = __builtin_amdgcn_exp2f(p1[r] - mnew); ls += p0[r] + p1[r]; }
    lrun = lrun * alpha + ls;
#pragma unroll
    for (int r = 0; r < 16; ++r) { oT[0][r] *= alpha; oT[1][r] *= alpha; }
    bf16x8 pf[4];
    { u32x4 w;
      w.x = pk_bf16(p0[0], p0[1]); w.y = pk_bf16(p0[2], p0[3]); w.z = pk_bf16(p0[4], p0[5]); w.w = pk_bf16(p0[6], p0[7]); pf[0] = __builtin_bit_cast(bf16x8, w);
      w.x = pk_bf16(p0[8], p0[9]); w.y = pk_bf16(p0[10], p0[11]); w.z = pk_bf16(p0[12], p0[13]); w.w = pk_bf16(p0[14], p0[15]); pf[1] = __builtin_bit_cast(bf16x8, w);
      w.x = pk_bf16(p1[0], p1[1]); w.y = pk_bf16(p1[2], p1[3]); w.z = pk_bf16(p1[4], p1[5]); w.w = pk_bf16(p1[6], p1[7]); pf[2] = __builtin_bit_cast(bf16x8, w);
      w.x = pk_bf16(p1[8], p1[9]); w.y = pk_bf16(p1[10], p1[11]); w.z = pk_bf16(p1[12], p1[13]); w.w = pk_bf16(p1[14], p1[15]); pf[3] = __builtin_bit_cast(bf16x8, w); }
    const LAS unsigned char* vt = bb + KT;
#pragma unroll
    for (int db = 0; db < 2; ++db)
#pragma unroll
        for (int cc = 0; cc < 4; ++cc) {
            const bf16x8 vf = *(const LAS bf16x8*)(vt + (32 * db + r32) * ROWB + cc * 32 + hi * 16);
            oT[db] = __builtin_amdgcn_mfma_f32_32x32x16_bf16(vf, pf[cc], oT[db], 0, 0, 0);
        }
}
__device__ __forceinline__ void attn_phase(LAS unsigned char* lds, const bf16_t* Q, const bf16_t* Kg, const bf16_t* Vg, bf16_t* O, const float* biasK, const float* qg, const float* kg) {
    const int tid = opaque_tid(), lane = tid & 63, wid = __builtin_amdgcn_readfirstlane(tid >> 6), r32 = lane & 31, hi = lane >> 5;
    const int G = gridDim.x, c = blockIdx.x;
    constexpr int ROWB = 144, KT = 64 * ROWB, BUF = 2 * KT + 256;
    const int kvr = tid >> 3, ch = tid & 7;
    const int slot = (kvr & ~15) | (kvr & 3) | ((kvr & 4) << 1) | ((kvr & 8) >> 1);
    float SB; { float a = fabsf(qg[lane]), b2 = fabsf(kg[lane]);
#pragma unroll
        for (int o = 1; o < 64; o <<= 1) { a = fmaxf(a, __shfl_xor(a, o)); b2 = fmaxf(b2, __shfl_xor(b2, o)); }
        SB = 64.0f * a * b2 * QSCALE * 1.02f; }
    for (int i = 0; i * G < 1024; ++i) {
        const int pidx = i * G + ((i & 1) ? (G - 1 - c) : c);
        if (pidx >= 1024) continue;
        const int qb = 15 - (pidx >> 6), bh = ((pidx & 63) + 9 * (pidx >> 8)) & 63, b = bh >> 4, h = bh & 15;
        const int q0 = qb * 512, NT = 8 * qb + 8;
        const size_t rowbase = (size_t)b * SEQ;
        bf16x8 qr[2][4];
#pragma unroll
        for (int sb = 0; sb < 2; ++sb)
#pragma unroll
            for (int d0 = 0; d0 < 4; ++d0) qr[sb][d0] = *(const bf16x8*)(Q + (rowbase + q0 + 256 * sb + wid * 32 + r32) * D + h * 64 + d0 * 16 + hi * 8);
        const float ref = biasK[(rowbase + q0 + 511) * 16 + h];
        const bf16_t* kp = Kg + (rowbase + kvr) * D + h * 64 + ch * 8;
        const bf16_t* vp = Vg + (rowbase + kvr) * D + h * 64 + ch * 8;
        const float* bp = biasK + (rowbase + (tid & 63)) * 16 + h;
        u32x4 kreg = *(const u32x4*)(kp + (size_t)(NT - 1) * 64 * D), vreg = *(const u32x4*)(vp + (size_t)(NT - 1) * 64 * D); float breg = (tid < 64) ? bp[(size_t)(NT - 1) * 64 * 16] - ref : 0.f;
#define ATT_WRITE(bufi) do { LAS unsigned char* bb_ = lds + (bufi) * BUF; \
            *(LAS u32x4*)(bb_ + kvr * ROWB + ch * 16) = kreg; \
            LAS bf16_t* vt_ = (LAS bf16_t*)(bb_ + KT) + (ch * 8) * (ROWB / 2) + slot; \
            vt_[0 * (ROWB / 2)] = (bf16_t)(vreg.x & 0xffff); vt_[1 * (ROWB / 2)] = (bf16_t)(vreg.x >> 16); \
            vt_[2 * (ROWB / 2)] = (bf16_t)(vreg.y & 0xffff); vt_[3 * (ROWB / 2)] = (bf16_t)(vreg.y >> 16); \
            vt_[4 * (ROWB / 2)] = (bf16_t)(vreg.z & 0xffff); vt_[5 * (ROWB / 2)] = (bf16_t)(vreg.z >> 16); \
            vt_[6 * (ROWB / 2)] = (bf16_t)(vreg.w & 0xffff); vt_[7 * (ROWB / 2)] = (bf16_t)(vreg.w >> 16); \
            if (tid < 64) ((LAS float*)(bb_ + 2 * KT))[tid] = breg; } while (0)
        ATT_WRITE((NT - 1) & 1);
        __syncthreads();
        float mrun[2] = {-1e30f, -1e30f}, lrun[2] = {0.f, 0.f};
        f32x16 oT[2][2];
#pragma unroll
        for (int r = 0; r < 16; ++r) { oT[0][0][r] = 0.f; oT[0][1][r] = 0.f; oT[1][0][r] = 0.f; oT[1][1][r] = 0.f; }
        for (int t = NT - 1; t >= 0; --t) {
            const int cur = t & 1;
            if (t > 0) { kreg = *(const u32x4*)(kp + (size_t)(t - 1) * 64 * D); vreg = *(const u32x4*)(vp + (size_t)(t - 1) * 64 * D); if (tid < 64) breg = bp[(size_t)(t - 1) * 64 * 16] - ref; }
            const LAS unsigned char* bb = lds + cur * BUF;
            const float bmax = ((const LAS float*)(bb + 2 * KT))[63];
            int dead = 1;
#pragma unroll
            for (int sb = 0; sb < 2; ++sb) {
                const int wq0 = q0 + 256 * sb + wid * 32;
                const int dsb = __all((SB + bmax - mrun[sb]) < -150.0f);
                if (64 * t <= wq0 + 31) {
                    if (!dsb) att_tile(bb, qr[sb], t, wq0, wq0 + r32, r32, hi, mrun[sb], lrun[sb], oT[sb]);
                    dead &= dsb;
                } else dead = 0;
            }
            if (t > 0) ATT_WRITE(cur ^ 1);
            { LAS int* fl = (LAS int*)(lds + 2 * BUF) + cur * 8;
              if (lane == 0) fl[wid] = dead;
              __syncthreads();
              const LAS u32x4* fv = (const LAS u32x4*)fl; const u32x4 f0 = fv[0], f1 = fv[1];
              if ((f0.x & f0.y & f0.z & f0.w & f1.x & f1.y & f1.z & f1.w) != 0u) break; }
        }
#undef ATT_WRITE
#pragma unroll
        for (int sb = 0; sb < 2; ++sb) {
            const float ltot = lrun[sb] + __shfl_xor(lrun[sb], 32);
            const float rl = 1.0f / ltot;
            bf16_t* op = O + (rowbase + q0 + 256 * sb + wid * 32 + r32) * D + h * 64;
#pragma unroll
            for (int db = 0; db < 2; ++db)
#pragma unroll
                for (int g4 = 0; g4 < 4; ++g4) { u32x2 w; w.x = pk_bf16(oT[sb][db][4 * g4] * rl, oT[sb][db][4 * g4 + 1] * rl); w.y = pk_bf16(oT[sb][db][4 * g4 + 2] * rl, oT[sb][db][4 * g4 + 3] * rl);
                    *(u32x2*)(op + 32 * db + 8 * g4 + 4 * hi) = w; }
        }
    }
}

template <bool PASS_B>
__device__ __forceinline__ void s5_phase(KP kp, LAS unsigned char* lds, const bf16_t* hb, const float* ss, const float* shiftl, f32x2* Ebuf, bf16_t* gout) {
    const int tid = opaque_tid(), lane = tid & 63, wid = __builtin_amdgcn_readfirstlane(tid >> 6), l31 = lane & 31, hi = lane >> 5;
    constexpr int XROW = 272;
    LAS unsigned char* xS = lds + wid * (32 * XROW);
    const float *lam_re = kp->in[14], *lam_im = kp->in[15], *log_dt = kp->in[16], *b_re = kp->in[17], *b_im = kp->in[18], *c_re = kp->in[19], *c_im = kp->in[20], *d_skip = kp->in[21];
    const int gw = blockIdx.x * NWAVES + wid, NGW = gridDim.x * NWAVES;
    const int arow = 128 * ((l31 >> 2) & 1) + (l31 & 3) + 4 * (l31 >> 3);
    int gprev = -1;
    float lbr[2] = {0.f, 0.f}, lbi[2] = {0.f, 0.f}, p128r[2] = {0.f, 0.f}, p128i[2] = {0.f, 0.f}; bf16x8 bbf[4]; bf16x8 cf[8], df[2];
    for (int it = gw; it < 8192; it += NGW) {
        const int g = it & 63, b = (it >> 6) & 3, cp = it >> 8, ck = 2 * cp + hi;
        const size_t rowA = (size_t)b * SEQ + cp * 256;
        const float* shp = shiftl + (size_t)b * NMOD + 16 * g + 8 * hi; const f32x4 sh0 = *(const f32x4*)shp, sh1 = *(const f32x4*)(shp + 4);
        u32x4 uraw; f32x4 sp[4];
#define S5_ULOAD(blk_) do { const size_t row_ = rowA + arow + 16 * (blk_); uraw = *(const u32x4*)(hb + row_ * D + 16 * g + 8 * hi); \
            _Pragma("unroll") for (int pn_ = 0; pn_ < 4; ++pn_) sp[pn_] = *(const f32x4*)(ss + ((size_t)pn_ * M + row_) * 4); } while (0)
#define S5_UPACK(dst_) do { float t_ = 0.f; _Pragma("unroll") for (int pn_ = 0; pn_ < 4; ++pn_) t_ += (sp[pn_][0] + sp[pn_][1]) + (sp[pn_][2] + sp[pn_][3]); const float r_ = rs_of(t_); \
            dst_ = __builtin_bit_cast(bf16x8, pack8((f32x4){bf_lo(uraw.x), bf_hi(uraw.x), bf_lo(uraw.y), bf_hi(uraw.y)} * r_ + sh0, (f32x4){bf_lo(uraw.z), bf_hi(uraw.z), bf_lo(uraw.w), bf_hi(uraw.w)} * r_ + sh1)); } while (0)
        S5_ULOAD(0);
        if (g != gprev) {
        gprev = g;
        const float dt = __expf(log_dt[g]);
#pragma unroll
        for (int s2 = 0; s2 < 2; ++s2) {
            const int gn = g * 64 + l31 + 32 * s2;
            const float ar = lam_re[gn], ai = lam_im[gn];
            const float mag = __expf(ar * dt);
            float th = ai * dt; { const float kq = rintf(th * 0.15915494309189535f); th = fmaf(-kq, 6.28318548202514648f, th); th = fmaf(-kq, -1.7484555e-7f, th); }
            lbr[s2] = mag * cosf(th); lbi[s2] = mag * sinf(th);
            const float den = ar * ar + ai * ai, nr = lbr[s2] - 1.0f, ni = lbi[s2];
            const float kr = (nr * ar + ni * ai) / den, ki = (ni * ar - nr * ai) / den;
            const f32x4 br0 = *(const f32x4*)(b_re + (size_t)gn * 16 + 8 * hi), br1 = *(const f32x4*)(b_re + (size_t)gn * 16 + 8 * hi + 4);
            const f32x4 bi0 = *(const f32x4*)(b_im + (size_t)gn * 16 + 8 * hi), bi1 = *(const f32x4*)(b_im + (size_t)gn * 16 + 8 * hi + 4);
            bbf[s2] = __builtin_bit_cast(bf16x8, pack8(br0 * kr - bi0 * ki, br1 * kr - bi1 * ki));
            bbf[2 + s2] = __builtin_bit_cast(bf16x8, pack8(bi0 * kr + br0 * ki, bi1 * kr + br1 * ki));
        }
        if (PASS_B) {
#pragma unroll
            for (int s2 = 0; s2 < 2; ++s2) {
                float pr = lbr[s2], pi = lbi[s2];
#pragma unroll
                for (int q = 0; q < 7; ++q) { const float t = pr * pr - pi * pi; pi = 2.0f * pr * pi; pr = t; }
                p128r[s2] = pr; p128i[s2] = pi;
            }
            const int ci = l31 & 15; const bool cv = l31 < 16;
#pragma unroll
            for (int ks = 0; ks < 8; ++ks) {
                const float* cp2 = (ks < 4 ? c_re : c_im) + ((size_t)g * 16 + ci) * 64 + 16 * (ks & 3) + 8 * hi;
                f32x4 a = *(const f32x4*)cp2, bq = *(const f32x4*)(cp2 + 4);
                if (ks >= 4) { a = -a; bq = -bq; }
                if (!cv) { a = (f32x4){0.f, 0.f, 0.f, 0.f}; bq = a; }
                cf[ks] = __builtin_bit_cast(bf16x8, pack8(a, bq));
            }
            { const float dv = d_skip[16 * g + ci]; const unsigned dh = pk_bf16(dv, 0.f) & 0xffffu; const float dl = dv - bf_lo(dh); const unsigned dlo = pk_bf16(dl, 0.f) & 0xffffu;
              bf16x8 z = {0, 0, 0, 0, 0, 0, 0, 0}; df[0] = z; df[1] = z;
              const int j = ci - 8 * hi;
#pragma unroll
              for (int jj = 0; jj < 8; ++jj) if (cv && jj == j) { df[0][jj] = (short)dh; df[1][jj] = (short)dlo; } }
        }
        }
        float xr[2] = {0.f, 0.f}, xi[2] = {0.f, 0.f};
        if (PASS_B) {
            const f32x2* Ep0 = Ebuf + (((size_t)b * 64 + g) * 64) * 64 + l31;
            const int ckmax = 2 * cp + 1;
            for (int cb0 = 0; cb0 < ckmax; cb0 += 4) {
                f32x2 e0[4], e1[4];
#pragma unroll
                for (int k = 0; k < 4; ++k) { const int c2 = (cb0 + k < ckmax) ? cb0 + k : ckmax - 1; e0[k] = Ep0[(size_t)c2 * 64]; e1[k] = Ep0[(size_t)c2 * 64 + 32]; }
#pragma unroll
                for (int k = 0; k < 4; ++k) if (cb0 + k < ck) {
                    float t = p128r[0] * xr[0] - p128i[0] * xi[0] + e0[k].x; xi[0] = p128r[0] * xi[0] + p128i[0] * xr[0] + e0[k].y; xr[0] = t;
                    t = p128r[1] * xr[1] - p128i[1] * xi[1] + e1[k].x; xi[1] = p128r[1] * xi[1] + p128i[1] * xr[1] + e1[k].y; xr[1] = t; }
            }
        }
        bf16x8 uf; S5_UPACK(uf);
#pragma unroll 1
        for (int blk = 0; blk < 8; ++blk) {
            if (blk < 7) S5_ULOAD(blk + 1);
            f32x16 bu[4];
            { f32x16 z;
#pragma unroll
              for (int r = 0; r < 16; ++r) z[r] = 0.f;
#pragma unroll
              for (int cb = 0; cb < 4; ++cb) bu[cb] = __builtin_amdgcn_mfma_f32_32x32x16_bf16(uf, bbf[cb], z, 0, 0, 0); }
#pragma unroll
            for (int r = 0; r < 16; ++r) {
#pragma unroll
                for (int s2 = 0; s2 < 2; ++s2) { const float t2 = lbr[s2] * xr[s2] - lbi[s2] * xi[s2] + bu[s2][r]; xi[s2] = lbr[s2] * xi[s2] + lbi[s2] * xr[s2] + bu[2 + s2][r]; xr[s2] = t2;
                    bu[s2][r] = xr[s2]; bu[2 + s2][r] = xi[s2]; }
            }
            if (PASS_B) {
#pragma unroll
                for (int r = 0; r < 16; ++r) { LAS bf16_t* xp = (LAS bf16_t*)(xS + crow(r, hi) * XROW) + l31;
#pragma unroll
                    for (int cb = 0; cb < 4; ++cb) xp[32 * cb] = (bf16_t)(pk_bf16(bu[cb][r], 0.f) & 0xffffu); }
                f32x16 y;
#pragma unroll
                for (int r = 0; r < 16; ++r) y[r] = 0.f;
                y = __builtin_amdgcn_mfma_f32_32x32x16_bf16(uf, df[0], y, 0, 0, 0);
                y = __builtin_amdgcn_mfma_f32_32x32x16_bf16(uf, df[1], y, 0, 0, 0);
#pragma unroll
                for (int ks = 0; ks < 8; ++ks) { const bf16x8 af = *(const LAS bf16x8*)(xS + l31 * XROW + (16 * ks + 8 * hi) * 2); y = __builtin_amdgcn_mfma_f32_32x32x16_bf16(af, cf[ks], y, 0, 0, 0); }
                {
                    const int roff = (l31 < 16) ? 0 : 8;
#pragma unroll
                    for (int k = 0; k < 8; ++k) {
                        const auto sw = __builtin_amdgcn_permlane16_swap(__float_as_uint(y[k]), __float_as_uint(y[8 + k]), false, false);
                        gout[(rowA + 128 * hi + 16 * blk + roff + k) * D + 16 * g + (l31 & 15)] = (bf16_t)(pk_bf16(gelu_tanh(__uint_as_float(sw[0])), 0.f) & 0xffffu); }
                }
            }
            if (blk < 7) S5_UPACK(uf);
        }
#undef S5_ULOAD
#undef S5_UPACK
        if (!PASS_B) {
#pragma unroll
            for (int s2 = 0; s2 < 2; ++s2) Ebuf[((((size_t)b * 64 + g) * 64) + ck) * 64 + l31 + 32 * s2] = (f32x2){xr[s2], xi[s2]};
        }
    }
}

#define XB_TMO      128
#define XB_XCNT(j)  (256  + 64 * (j))
#define XB_XSUB(j)  (1280 + 64 * (j))
#define XB_XGEN(j)  (2304 + 64 * (j))
#define XB_TOP      3328
#define XB_TOPGEN   3392
#define XCD_BAR_WORDS 3456
#define XB_SPIN_CAP (1u << 18)

__device__ __forceinline__ unsigned xb_ld(unsigned* p)              { return __hip_atomic_load(p, __ATOMIC_RELAXED, __HIP_MEMORY_SCOPE_AGENT); }
__device__ __forceinline__ unsigned xb_add(unsigned* p, unsigned v) { return __hip_atomic_fetch_add(p, v, __ATOMIC_RELAXED, __HIP_MEMORY_SCOPE_AGENT); }
__device__ __forceinline__ unsigned xb_xcc_id() { return (unsigned)__builtin_amdgcn_s_getreg((3 << 11) | 20) & 0xFu; }
#define XB_SPIN(cond, bar) do { unsigned _sp = 0; while (cond) { __builtin_amdgcn_s_sleep(1); \
    if ((++_sp & 255u) == 0u) { if (xb_ld(&(bar)[XB_TMO])) break; if (_sp > XB_SPIN_CAP) { atomicAdd(&(bar)[XB_TMO], 1u); break; } } } } while (0)

struct XcdBarrier {
    unsigned* bar; unsigned x;
    volatile LAS unsigned* st;
};

__device__ __forceinline__ XcdBarrier xcd_barrier_post(unsigned* bar, volatile LAS unsigned* st) {
    XcdBarrier b; b.bar = bar; b.x = xb_xcc_id(); b.st = st;
    if (threadIdx.x == 0) (void)xb_add(&bar[XB_XCNT(b.x)], 1u);
    return b;
}
__device__ __forceinline__ void xcd_barrier_complete(unsigned* bar, unsigned x, unsigned& nloc, unsigned& nx) {
    const unsigned G = gridDim.x * gridDim.y * gridDim.z;
    unsigned sum, cnt, mine, sp = 0u;
    for (;;) {
        sum = 0u; cnt = 0u; mine = 0u;
#pragma unroll
        for (unsigned j = 0; j < 16; ++j) { const unsigned c = xb_ld(&bar[XB_XCNT(j)]); sum += c; cnt += (c > 0u) ? 1u : 0u; mine = (j == x) ? c : mine; }
        if (sum == G) break;
        __builtin_amdgcn_s_sleep(1);
        if ((++sp & 255u) == 0u) { if (xb_ld(&bar[XB_TMO])) break; if (sp > XB_SPIN_CAP) { atomicAdd(&bar[XB_TMO], 1u); break; } }
    }
    nloc = mine > 0u ? mine : 1u; nx = cnt > 0u ? cnt : 1u;
}

__device__ __forceinline__ void xcd_barrier(const XcdBarrier& b) {
    asm volatile("s_waitcnt vmcnt(0)" ::: "memory");
    __syncthreads();
    if (threadIdx.x == 0) {
        unsigned* bar = b.bar;
        __builtin_amdgcn_s_waitcnt(0);
        unsigned nloc = b.st[0], nx = b.st[1];
        if (nloc == 0u) { xcd_barrier_complete(bar, b.x, nloc, nx); b.st[0] = nloc; b.st[1] = nx; }
        const unsigned old = xb_add(&bar[XB_XSUB(b.x)], 1u);
        const unsigned gen = old / nloc;
        if (old + 1u == (gen + 1u) * nloc) {
            __builtin_amdgcn_fence(__ATOMIC_RELEASE, "agent");
            asm volatile("s_waitcnt vmcnt(0)" ::: "memory");
            const unsigned og = xb_add(&bar[XB_TOP], 1u);
            const unsigned tg = og / nx;
            if (og + 1u == (tg + 1u) * nx) xb_add(&bar[XB_TOPGEN], 1u);
            else XB_SPIN(xb_ld(&bar[XB_TOPGEN]) == tg, bar);
            __builtin_amdgcn_fence(__ATOMIC_ACQUIRE, "agent");
            xb_add(&bar[XB_XGEN(b.x)], 1u);
            asm volatile("s_waitcnt vmcnt(0)" ::: "memory");
        } else {
            XB_SPIN(xb_ld(&bar[XB_XGEN(b.x)]) == gen, bar);
            __builtin_amdgcn_fence(__ATOMIC_ACQUIRE, "agent");
            asm volatile("s_waitcnt vmcnt(0)" ::: "memory");
        }
    }
    __syncthreads();
}


enum Kind { K_PROLOGUE, K_NORM, K_FFNIN, K_FFNOUT, K_POOL_EW, K_POOL_GEMM, K_QKV, K_CUMSUM, K_ATTN, K_WO, K_S5A, K_S5B, K_GLU, K_CONVIN, K_CONV_EW, K_CONVOUT };
constexpr int NPHASES = 2 + 6 + 8 + 7 + 7;
__host__ __device__ inline void decode_phase(int ph, int& layer, int& kind, int& sub) {
    layer = 0; sub = 0; kind = K_PROLOGUE; if (ph == 0) return;
    if (ph == 1) { kind = K_NORM; return; }
    int r = ph - 2;
    for (int l = 0; l < 4; ++l) {
        const int nm = (l == 0) ? 2 : (l == 1 ? 4 : 3), n = 4 + nm;
        if (r < n) { layer = l;
            if (r < 2) { sub = 0; kind = r == 0 ? K_FFNIN : K_FFNOUT; }
            else if (r < 2 + nm) { sub = 1; const int q = r - 2;
                kind = l == 0 ? (q == 0 ? K_POOL_EW : K_POOL_GEMM) : l == 1 ? (q == 0 ? K_QKV : q == 1 ? K_CUMSUM : q == 2 ? K_ATTN : K_WO)
                     : l == 2 ? (q == 0 ? K_S5A : q == 1 ? K_S5B : K_GLU) : (q == 0 ? K_CONVIN : q == 1 ? K_CONV_EW : K_CONVOUT); }
            else { sub = 2; const int q = r - 2 - nm; kind = q == 0 ? K_FFNIN : K_FFNOUT; }
            return; }
        r -= n;
    }
}

__global__ void __launch_bounds__(NTHREADS, 2) mega_fwd(Params p_arg) {
    extern __shared__ __attribute__((aligned(16))) unsigned char lds_raw[];
    LAS unsigned char* lds = (LAS unsigned char*)lds_raw;
    cg::grid_group grid = cg::this_grid();
    const KP kp0 = (KP)__builtin_amdgcn_kernarg_segment_ptr();
    const int lo = kp0->lo, hi = kp0->hi;
    volatile LAS unsigned* bst = (volatile LAS unsigned*)(lds + LDS_MAIN + LDS_SSL);
    if (threadIdx.x < 4) bst[threadIdx.x] = 0u;
    __syncthreads();
    const XcdBarrier xbar = xcd_barrier_post((unsigned*)(kp0->ws + WS_BAR), bst);
#define WSP(T, off) ((T*)(ws + (off)))
    for (int ph = lo; ph < hi; ++ph) {
        KP kp = kp0; asm volatile("" : "+s"(kp));
        int layer, kind, sub; decode_phase(ph, layer, kind, sub);
        const int reps = 1 + ((REPMASK >> kind) & 1);
        for (int rep = 0; rep < reps; ++rep) {
        if (rep) xcd_barrier(xbar);
        unsigned char* ws = kp->ws;
        const int sidx = layer * 3 + sub;
        switch (kind) {
        case K_PROLOGUE: prologue_phase(kp, lds, rep); break;
        case K_NORM: norm0_phase(kp); break;
        case K_FFNIN: {
            const int ffi = layer * 2 + (sub == 2 ? 1 : 0);
            const pg8::Gemm g{WSP(const bf16_t, WS_HB), WSP(const bf16_t, WS_WFFIN) + (size_t)ffi * 2 * DFF * D, M, 2 * DFF, D, D, 0};
            pg8::StaticOrder S; S.init(M, 2 * DFF, gridDim.x, blockIdx.x);
            const EpiSwiglu E{WSP(bf16_t, WS_HH), WSP(const float, WS_SS) + (size_t)(sidx & 1) * 16 * M, WSP(const float, WS_BIASV) + (size_t)ffi * BV_FFN, (const LAS float*)(lds + LDS_MAIN)};
            pg8::gemm_phase<EpiSwiglu, true>(lds, g, S, E);
        } break;
        case K_QKV: {
            const pg8::Gemm g{WSP(const bf16_t, WS_HB), WSP(const bf16_t, WS_WFOXIN), M, NFOX, D, D, 0};
            pg8::StaticOrder S; S.init(M, NFOX, gridDim.x, blockIdx.x);
            const EpiQKV E{WSP(bf16_t, WS_R2), WSP(float, WS_LOGF), kp->in[11], kp->in[12], kp->in[10], WSP(const float, WS_SS) + (size_t)(sidx & 1) * 16 * M, WSP(const float, WS_BIASV) + BV_QKV_OFF, (const LAS float*)(lds + LDS_MAIN)};
            pg8::gemm_phase<EpiQKV, true>(lds, g, S, E);
        } break;
        case K_CONVIN: {
            const pg8::Gemm g{WSP(const bf16_t, WS_HB), WSP(const bf16_t, WS_WCONVIN), M, 3 * D, D, D, 0};
            pg8::StaticOrder S; S.init(M, 3 * D, gridDim.x, blockIdx.x);
            const EpiConvIn E{WSP(bf16_t, WS_R2), WSP(bf16_t, WS_R3), WSP(const float, WS_SS) + (size_t)(sidx & 1) * 16 * M, WSP(const float, WS_BIASV) + BV_CONV_OFF, (const LAS float*)(lds + LDS_MAIN)};
            pg8::gemm_phase<EpiConvIn, true>(lds, g, S, E);
        } break;
        case K_FFNOUT: case K_POOL_GEMM: case K_WO: case K_GLU: case K_CONVOUT: {
            const int ffi = layer * 2 + (sub == 2 ? 1 : 0);
            size_t aoff = WS_R2, boff; int K = D, lda = D, apn = 0; float coef = 1.0f; const float* colscale = nullptr; const bf16_t* glu = nullptr;
            if (kind == K_FFNOUT) { aoff = WS_HH; boff = WS_WFFOUT + (size_t)ffi * D * DFF * 2; K = DFF; lda = DFF; coef = 0.5f; }
            else if (kind == K_POOL_GEMM) { boff = WS_WPOOL; K = 256; apn = 256; colscale = kp->in[8]; }
            else if (kind == K_WO) { aoff = WS_HH; boff = WS_WFOXO; }
            else if (kind == K_GLU) { boff = WS_WGLU; glu = WSP(const bf16_t, WS_R2); }
            else { aoff = WS_R4; boff = WS_WCONVOUT; }
            const pg8::Gemm g{WSP(const bf16_t, aoff), WSP(const bf16_t, boff), M, D, K, lda, apn};
            pg8::StaticOrder S; S.init(M, D, gridDim.x, blockIdx.x);
            if (kind == K_GLU) {
                const EpiRes<true> E{WSP(const _Float16, WS_XH), nullptr, WSP(_Float16, WS_XH), WSP(const float, WS_MOD) + (size_t)layer * 4 * NMOD + (sub * 3 + 2) * D, colscale, glu,
                                     WSP(const float, WS_GS) + (size_t)(sidx + 1) * 4 * D, WSP(float, WS_SS) + (size_t)((sidx + 1) & 1) * 16 * M, WSP(bf16_t, WS_HB), (rep + 1 < reps) ? 0.0f : coef, 0};
                pg8::gemm_phase<EpiRes<true>, true>(lds, g, S, E);
            } else {
                const EpiRes<false> E{WSP(const _Float16, WS_XH), sidx == 11 ? kp->out : nullptr, WSP(_Float16, WS_XH), WSP(const float, WS_MOD) + (size_t)layer * 4 * NMOD + (sub * 3 + 2) * D, colscale, glu,
                                      sidx < 11 ? WSP(const float, WS_GS) + (size_t)(sidx + 1) * 4 * D : nullptr, WSP(float, WS_SS) + (size_t)((sidx + 1) & 1) * 16 * M, WSP(bf16_t, WS_HB), (rep + 1 < reps) ? 0.0f : coef, 0};
                pg8::gemm_phase<EpiRes<false>, true>(lds, g, S, E);
            }
        } break;
        case K_POOL_EW: pool_phase(WSP(const bf16_t, WS_HB), WSP(const float, WS_SS) + (size_t)(sidx & 1) * 16 * M, WSP(const float, WS_MOD) + (size_t)layer * 4 * NMOD + 3 * D, WSP(bf16_t, WS_R2)); break;
        case K_CUMSUM: cumsum_phase(WSP(const float, WS_LOGF), WSP(float, WS_BIASK), lds); break;
        case K_ATTN: attn_phase(lds, WSP(const bf16_t, WS_R2), WSP(const bf16_t, WS_R3), WSP(const bf16_t, WS_R4), WSP(bf16_t, WS_HH), WSP(const float, WS_BIASK), kp->in[11], kp->in[12]); break;
        case K_S5A: s5_phase<false>(kp, lds, WSP(const bf16_t, WS_HB), WSP(const float, WS_SS) + (size_t)(sidx & 1) * 16 * M, WSP(const float, WS_MOD) + (size_t)layer * 4 * NMOD + 3 * D, WSP(f32x2, WS_E), WSP(bf16_t, WS_R2)); break;
        case K_S5B: s5_phase<true>(kp, lds, WSP(const bf16_t, WS_HB), WSP(const float, WS_SS) + (size_t)(sidx & 1) * 16 * M, WSP(const float, WS_MOD) + (size_t)layer * 4 * NMOD + 3 * D, WSP(f32x2, WS_E), WSP(bf16_t, WS_R2)); break;
        case K_CONV_EW: conv_phase(WSP(const bf16_t, WS_R2), WSP(const bf16_t, WS_R3), kp->in[24], WSP(bf16_t, WS_R4)); break;
        default: break;
        }
        }
        if (ph + 1 < hi) { if (ph == lo) grid.sync(); else xcd_barrier(xbar); }
    }
#undef WSP
}

extern "C" void kernel_launch(void* const* d_in, const int* in_sizes, int n_in, void* d_out, int out_size, void* d_ws, size_t ws_size, hipStream_t stream) {
    static int grid = 0;
    if (grid == 0) {
        if (n_in != 26 || out_size != M * D || ws_size < WS_END) { fprintf(stderr, "kernel_launch: unexpected shapes (n_in %d out %d ws %zu)\n", n_in, out_size, ws_size); grid = -1; return; }
        int dev = 0, cus = 0, per_cu = 0;
        (void)hipGetDevice(&dev); (void)hipDeviceGetAttribute(&cus, hipDeviceAttributeMultiprocessorCount, dev);
        if (hipFuncSetAttribute((const void*)mega_fwd, hipFuncAttributeMaxDynamicSharedMemorySize, LDS_BYTES) != hipSuccess) { fprintf(stderr, "kernel_launch: hipFuncSetAttribute failed\n"); grid = -1; return; }
        if (hipOccupancyMaxActiveBlocksPerMultiprocessor(&per_cu, (const void*)mega_fwd, NTHREADS, LDS_BYTES) != hipSuccess || per_cu < 1) { fprintf(stderr, "kernel_launch: occupancy query gave %d\n", per_cu); per_cu = 1; }
        (void)hipGetLastError();
        grid = cus * per_cu;
        fprintf(stderr, "kernel_launch: grid %d (cus %d x %d)\n", grid, cus, per_cu);
    }
    if (grid < 0) return;
    (void)hipMemsetAsync((unsigned char*)d_ws + WS_BAR, 0, BAR_BYTES, stream);
    Params p{};
    for (int i = 0; i < 26; ++i) p.in[i] = (const float*)d_in[i];
    p.out = (float*)d_out; p.ws = (unsigned char*)d_ws;
#if MK_ONE_LAUNCH
    p.lo = 0; p.hi = NPHASES;
    void* args[] = {&p};
    hipError_t e = hipLaunchCooperativeKernel((const void*)mega_fwd, dim3(grid), dim3(NTHREADS), args, LDS_BYTES, stream);
    if (e != hipSuccess) fprintf(stderr, "cooperative launch failed: %s (grid %d)\n", hipGetErrorString(e), grid);
#else
    for (int ph = 0; ph < NPHASES; ++ph) {
        p.lo = ph; p.hi = ph + 1;
        hipLaunchKernelGGL(mega_fwd, dim3(grid), dim3(NTHREADS), LDS_BYTES, stream, p);
    }
#endif
}
```

```cpp
#include <hip/hip_runtime.h>
#include <hip/hip_cooperative_groups.h>
#include <cstdio>
#include <cstdint>
namespace cg = cooperative_groups;

#ifndef REPMASK
#define REPMASK 0
#endif
#ifndef MK_ONE_LAUNCH
#define MK_ONE_LAUNCH 1
#endif

#define LAS __attribute__((address_space(3)))
typedef unsigned short bf16_t;
typedef short bf16x8 __attribute__((ext_vector_type(8)));
typedef float f32x4 __attribute__((ext_vector_type(4)));
typedef float f32x2 __attribute__((ext_vector_type(2)));
typedef float f32x16 __attribute__((ext_vector_type(16)));
typedef unsigned u32x4 __attribute__((ext_vector_type(4)));
typedef unsigned u32x2 __attribute__((ext_vector_type(2)));
typedef __bf16 bf16x2_t __attribute__((ext_vector_type(2)));
typedef _Float16 h16x4 __attribute__((ext_vector_type(4)));

constexpr int D = 1024, BATCH = 4, SEQ = 8192, M = BATCH * SEQ, DFF = 2816, NMOD = 9 * D;
constexpr int NFOX = 3328;
constexpr float EPS = 1e-6f;
constexpr float LOG2E = 1.4426950408889634f;
constexpr float QSCALE = 0.125f * LOG2E;
constexpr int NTHREADS = 512, NWAVES = 8;
constexpr int LDS_MAIN = 131072, LDS_SSL = 16384 + 2048, LDS_BYTES = LDS_MAIN + LDS_SSL + 64;

constexpr size_t MiB = 1u << 20;
constexpr size_t WS_MOD = 0, WS_LOGF = 1 * MiB, WS_BIASK = 3 * MiB, WS_E = 5 * MiB, WS_BAR = 13 * MiB, BAR_BYTES = 16384;
constexpr size_t WS_WFFIN = 16 * MiB, WS_WFFOUT = 104 * MiB, WS_WFOXIN = 148 * MiB, WS_WFOXO = 155 * MiB, WS_WGLU = 157 * MiB,
                 WS_WCONVIN = 159 * MiB, WS_WCONVOUT = 165 * MiB, WS_WPOOL = 167 * MiB;
constexpr size_t WS_SS = 172 * MiB, WS_BIASV = 170 * MiB, WS_GS = 171 * MiB;
constexpr int BV_FFN = 4 * 2 * DFF, BV_QKV_OFF = 8 * BV_FFN, BV_CONV_OFF = BV_QKV_OFF + 4 * NFOX, BV_TOTAL = BV_CONV_OFF + 4 * 3 * D;
constexpr size_t WS_HB = 176 * MiB, WS_HH = 240 * MiB, WS_R2 = 416 * MiB, WS_R3 = 480 * MiB, WS_R4 = 544 * MiB, WS_XH = 608 * MiB, WS_END = 672 * MiB;

struct Params { const float* in[26]; float* out; unsigned char* ws; int lo, hi; };
typedef const __attribute__((address_space(4))) Params* KP;

__device__ __forceinline__ unsigned pk_bf16(float lo, float hi) { f32x2 v = {lo, hi}; bf16x2_t b = __builtin_convertvector(v, bf16x2_t); return __builtin_bit_cast(unsigned, b); }
__device__ __forceinline__ float bf_lo(unsigned w) { return __uint_as_float(w << 16); }
__device__ __forceinline__ float bf_hi(unsigned w) { return __uint_as_float(w & 0xffff0000u); }
__device__ __forceinline__ float wave_sum(float v) {
#pragma unroll
    for (int o = 1; o < 64; o <<= 1) v += __shfl_xor(v, o);
    return v;
}
__device__ __forceinline__ float fast_sigmoid(float x) { return __builtin_amdgcn_rcpf(1.0f + __builtin_amdgcn_exp2f(-x * LOG2E)); }
__device__ __forceinline__ float silu_f(float x) { return x * fast_sigmoid(x); }
__device__ __forceinline__ float gelu_tanh(float y) {
    const float z = 0.7978845608028654f * (y + 0.044715f * y * y * y);
    const float t = 1.0f - 2.0f * __builtin_amdgcn_rcpf(1.0f + __builtin_amdgcn_exp2f(2.0f * LOG2E * z));
    return 0.5f * y * (1.0f + t);
}
__device__ __forceinline__ float rs_of(float ss) { return rsqrtf(ss * (1.0f / D) + EPS); }
__device__ __forceinline__ float rs_row(const float* ssp, size_t row) { float t = 0.f;
#pragma unroll
    for (int pn = 0; pn < 4; ++pn) { const f32x4 v = *(const f32x4*)(ssp + ((size_t)pn * M + row) * 4); t += (v[0] + v[1]) + (v[2] + v[3]); }
    return rs_of(t); }
__device__ __forceinline__ float log_sigmoid(float z) { return fminf(z, 0.f) - 0.6931471805599453f * __builtin_amdgcn_logf(1.0f + __builtin_amdgcn_exp2f(-fabsf(z) * LOG2E)); }

__device__ __forceinline__ int opaque_tid() { int t = threadIdx.x; asm volatile("" : "+v"(t)); return t; }
template <int OFF> __device__ __forceinline__ void gld16(f32x4& v, const void* p) { asm volatile("global_load_dwordx4 %0, %1, off offset:%2" : "=&v"(v) : "v"(p), "i"(OFF) : "memory"); }
template <int OFF> __device__ __forceinline__ void gld8(u32x2& v, const void* p) { asm volatile("global_load_dwordx2 %0, %1, off offset:%2" : "=&v"(v) : "v"(p), "i"(OFF) : "memory"); }
__device__ __forceinline__ void gwait8(f32x4 (&v)[8]) { asm volatile("s_waitcnt vmcnt(0)" : "+v"(v[0]), "+v"(v[1]), "+v"(v[2]), "+v"(v[3]), "+v"(v[4]), "+v"(v[5]), "+v"(v[6]), "+v"(v[7]) :: "memory"); }
__device__ __forceinline__ void gwait4(f32x4 (&v)[4]) { asm volatile("s_waitcnt vmcnt(0)" : "+v"(v[0]), "+v"(v[1]), "+v"(v[2]), "+v"(v[3]) :: "memory"); }
__device__ __forceinline__ void gwait8u(u32x2 (&v)[8]) { asm volatile("s_waitcnt vmcnt(0)" : "+v"(v[0]), "+v"(v[1]), "+v"(v[2]), "+v"(v[3]), "+v"(v[4]), "+v"(v[5]), "+v"(v[6]), "+v"(v[7]) :: "memory"); }
__device__ __forceinline__ void load_r8(const float* ssp, int row0, int fq, float (&r8)[2][4]) {
    f32x4 pv[8]; const float* p0 = ssp + ((size_t)fq * M + row0) * 4;
    gld16<0>(pv[0], p0); gld16<256>(pv[1], p0); gld16<512>(pv[2], p0); gld16<768>(pv[3], p0);
    gld16<2048>(pv[4], p0); gld16<2304>(pv[5], p0); gld16<2560>(pv[6], p0); gld16<2816>(pv[7], p0);
    gwait8(pv);
#pragma unroll
    for (int i = 0; i < 8; ++i) { float t = (pv[i][0] + pv[i][1]) + (pv[i][2] + pv[i][3]); t += __shfl_xor(t, 16); t += __shfl_xor(t, 32); r8[i >> 2][i & 3] = rs_of(t); }
}
__device__ __forceinline__ void load_r8_lds(const LAS float* ssl, int wr, int fr, int fq, float (&r8)[2][4]) {
#pragma unroll
    for (int i = 0; i < 8; ++i) { const f32x4 v = *(const LAS f32x4*)(ssl + (fq * 256 + (i >> 2) * 128 + wr * 64 + (i & 3) * 16 + fr) * 4);
        float t = (v[0] + v[1]) + (v[2] + v[3]); t += __shfl_xor(t, 16); t += __shfl_xor(t, 32); r8[i >> 2][i & 3] = rs_of(t); }
}
namespace pg8 {
constexpr int BM = 256, BK = 64, HALF = 128, HTB = HALF * BK * 2, STAGE_BYTES = 8 * HTB, NXCD = 8, WGM = 8;
__host__ __device__ __forceinline__ int lds_byte(int r, int c) { const int st = (r >> 4) * 2 + (c >> 5), rr = r & 15, cc = c & 31, ob = rr * 64 + cc * 2; return st * 1024 + (ob ^ (((ob >> 9) & 1) << 5)); }
__host__ __device__ __forceinline__ void stage_rc(int b, int& R, int& C) { const int st = b / 1024, sb = b % 1024, swz = sb ^ (((sb >> 9) & 1) << 5); R = (st >> 1) * 16 + swz / 64; C = (st & 1) * 32 + (swz % 64) / 2; }
__host__ __device__ __forceinline__ int perm32(int rho) { const int n = rho >> 4, i = rho & 15; return 8 * (i >> 2) + 4 * n + (i & 3); }
struct Unit { int pm, pn; };
struct Gemm { const bf16_t* A; const bf16_t* Bt; int M, N, K, lda, apn; };
struct StaticOrder {
    int nM, nN, nwg, G, c;
    __device__ void init(int M_, int N_, int G_, int c_) { nM = M_ / BM; nN = N_ / BM; nwg = nM * nN; G = G_; c = c_; }
    __device__ bool next(int i, Unit& u) const {
        const long L = (long)i * G + c; if (L >= nwg) return false;
        int wgid = (int)L; { const int q = nwg / NXCD, r = nwg % NXCD, xcd = wgid % NXCD, off = wgid / NXCD; wgid = (xcd < r ? xcd * (q + 1) : r * (q + 1) + (xcd - r) * q) + off; }
        const int nig = WGM * nN, gid = wgid / nig, fm = gid * WGM, gsz = (nM - fm) < WGM ? (nM - fm) : WGM;
        u.pm = fm + ((wgid % nig) % gsz); u.pn = (wgid % nig) / gsz; return true;
    }
};
template <class Epi, bool PG8_ALIGN_EPI>
__device__ __forceinline__ void gemm_phase(LAS unsigned char* lds, const Gemm g, const StaticOrder& S, const Epi& E) {
    const int tid = opaque_tid(), wid = __builtin_amdgcn_readfirstlane(tid >> 6), lane = tid & 63, wr = wid >> 2, wc = wid & 3, fr = lane & 15, fq = lane >> 4;
    const int K = g.K, nt = K / BK;
    unsigned voffA[2], voffB[2];
#pragma unroll
    for (int i = 0; i < 2; ++i) { int R, C; stage_rc(tid * 16 + i * 8192, R, C); const int Rb = (R & ~31) + perm32(R & 31);
        voffA[i] = (unsigned)(R * g.lda + C) * 2u; voffB[i] = (unsigned)(Rb * K + C) * 2u; }
    const size_t kstep = (size_t)(BK * 2);
    const size_t hstepA = (size_t)HALF * g.lda * 2, hstepB = (size_t)HALF * K * 2;
    const size_t tstepA = 2 * hstepA, tstepB = 2 * hstepB;
    const size_t apnb = (size_t)g.apn * 2;
    const unsigned ldsw = (unsigned)wid * 1024u;
    const int aoff = lds_byte(wr * 64 + fr, fq * 8), boff = lds_byte(wc * 32 + fr, fq * 8);
#define PG8_SA(b, h) (((b) * 2 + (h)) * HTB)
#define PG8_SB(b, h) ((4 + (b) * 2 + (h)) * HTB)
#define PG8_STAGE(bufoff, gbase, voff) do { _Pragma("unroll") for (int _i = 0; _i < 2; ++_i) \
        __builtin_amdgcn_global_load_lds((const unsigned*)((const char*)(gbase) + (voff)[_i]), (LAS unsigned*)(lds + (bufoff) + ldsw + _i * 8192), 16, 0, 0); } while (0)
#define PG8_LDA(dst, b, h) do { _Pragma("unroll") for (int m = 0; m < 4; ++m) _Pragma("unroll") for (int k = 0; k < 2; ++k) dst[m][k] = *(const LAS bf16x8*)(lds + PG8_SA(b, h) + aoff + m * 2048 + k * 1024); } while (0)
#define PG8_LDB(dst, b, h) do { _Pragma("unroll") for (int n = 0; n < 2; ++n) _Pragma("unroll") for (int k = 0; k < 2; ++k) dst[n][k] = *(const LAS bf16x8*)(lds + PG8_SB(b, h) + boff + n * 2048 + k * 1024); } while (0)
#define PG8_MMA(ai, bj, At, Bt) do { __builtin_amdgcn_s_setprio(1); _Pragma("unroll") for (int m = 0; m < 4; ++m) _Pragma("unroll") for (int n = 0; n < 2; ++n) _Pragma("unroll") for (int k = 0; k < 2; ++k) \
        acc[ai][bj][m][n] = __builtin_amdgcn_mfma_f32_16x16x32_bf16(Bt[n][k], At[m][k], acc[ai][bj][m][n], 0, 0, 0); __builtin_amdgcn_s_setprio(0); } while (0)
#define PG8_WAIT_V(n) asm volatile("s_waitcnt vmcnt(" #n ")" ::: "memory")
#define PG8_WAIT_L(n) asm volatile("s_waitcnt lgkmcnt(" #n ")" ::: "memory")
#define PG8_BAR __builtin_amdgcn_s_barrier()
#define PG8_SCHED __builtin_amdgcn_sched_barrier(0)
    Unit cur, nxt; int ui = 0;
    if (!S.next(0, cur)) return;
    f32x4 acc[2][2][4][2];
#pragma unroll
    for (int a = 0; a < 2; ++a)
#pragma unroll
        for (int b = 0; b < 2; ++b)
#pragma unroll
            for (int m = 0; m < 4; ++m)
#pragma unroll
                for (int n = 0; n < 2; ++n) acc[a][b][m][n] = (f32x4){0.f, 0.f, 0.f, 0.f};
    bf16x8 At[4][2], B0[2][2], B1[2][2];
    const char* cA = (const char*)g.A + (size_t)cur.pm * tstepA + (size_t)cur.pn * apnb; const char* cB = (const char*)g.Bt + (size_t)cur.pn * tstepB;
    PG8_STAGE(PG8_SB(0, 0), cB, voffB); PG8_STAGE(PG8_SB(0, 1), cB + hstepB, voffB); PG8_STAGE(PG8_SA(0, 0), cA, voffA); PG8_STAGE(PG8_SA(0, 1), cA + hstepA, voffA);
    if (wr == 1) PG8_BAR;
    PG8_WAIT_V(2); PG8_BAR;
    PG8_STAGE(PG8_SB(1, 0), cB + kstep, voffB); PG8_STAGE(PG8_SA(1, 0), cA + kstep, voffA); PG8_STAGE(PG8_SB(1, 1), cB + hstepB + kstep, voffB);
    PG8_WAIT_V(6); PG8_BAR;
#define PG8_SSDMA(u_) do { if constexpr (Epi::HAS_SS) { int ln_ = lane; asm volatile("" : "+v"(ln_)); const int pn_ = wid >> 1; \
        _Pragma("unroll") for (int jj_ = 0; jj_ < 2; ++jj_) { const int j_ = 2 * (wid & 1) + jj_; \
            __builtin_amdgcn_global_load_lds((const unsigned*)(E.ss + ((size_t)pn_ * M + 256 * (u_).pm + 64 * j_ + ln_) * 4), (LAS unsigned*)(lds + LDS_MAIN + (pn_ * 256 + 64 * j_) * 16), 16, 0, 0); } \
        if (wid < Epi::NAUX) __builtin_amdgcn_global_load_lds((const unsigned*)E.aux(wid, (u_), ln_), (LAS unsigned*)(lds + LDS_MAIN + 16384 + wid * 1024), 16, 0, 0); } } while (0)
    PG8_SSDMA(cur);
    for (;;) {
        const bool has_next = S.next(ui + 1, nxt);
        const char* nA = has_next ? (const char*)g.A + (size_t)nxt.pm * tstepA + (size_t)nxt.pn * apnb : cA; const char* nB = has_next ? (const char*)g.Bt + (size_t)nxt.pn * tstepB : cB;
        for (int t = 0; t < nt; t += 2) {
            const bool last = (t == nt - 2);
            const char* a1 = cA + (size_t)(t + 1) * kstep;
            const char* a2 = last ? nA : cA + (size_t)(t + 2) * kstep; const char* b2 = last ? nB : cB + (size_t)(t + 2) * kstep;
            const char* a3 = a2 + kstep; const char* b3 = b2 + kstep;
            PG8_LDB(B0, 0, 0); PG8_LDB(B1, 0, 1); PG8_SCHED; PG8_LDA(At, 0, 0); PG8_STAGE(PG8_SA(1, 1), a1 + hstepA, voffA);
            PG8_WAIT_V(8); PG8_WAIT_L(0); PG8_BAR;
            PG8_MMA(0, 0, At, B0); PG8_MMA(0, 1, At, B1); PG8_BAR; PG8_SCHED;
            PG8_LDA(At, 0, 1); PG8_STAGE(PG8_SB(0, 0), b2, voffB); PG8_STAGE(PG8_SB(0, 1), b2 + hstepB, voffB); PG8_STAGE(PG8_SA(0, 0), a2, voffA);
            PG8_WAIT_V(8); PG8_WAIT_L(0); PG8_BAR; PG8_MMA(1, 0, At, B0); PG8_MMA(1, 1, At, B1); PG8_BAR; PG8_SCHED;
            PG8_LDB(B0, 1, 0); PG8_LDB(B1, 1, 1); PG8_SCHED; PG8_LDA(At, 1, 0); PG8_STAGE(PG8_SA(0, 1), a2 + hstepA, voffA);
            PG8_WAIT_V(8); PG8_WAIT_L(0); PG8_BAR; PG8_MMA(0, 0, At, B0); PG8_MMA(0, 1, At, B1); PG8_BAR; PG8_SCHED;
            PG8_LDA(At, 1, 1); PG8_STAGE(PG8_SB(1, 0), b3, voffB); PG8_STAGE(PG8_SB(1, 1), b3 + hstepB, voffB); PG8_STAGE(PG8_SA(1, 0), a3, voffA);
            PG8_WAIT_V(8); PG8_WAIT_L(0); PG8_BAR; PG8_MMA(1, 0, At, B0); PG8_MMA(1, 1, At, B1); PG8_BAR; PG8_SCHED;
        }
        if (PG8_ALIGN_EPI) { if (wr == 0) PG8_BAR; }
        { int fr_e = fr, fq_e = fq; asm volatile("" : "+v"(fr_e), "+v"(fq_e));
          E(acc, cur, wr, wc, fr_e, fq_e); }
        if (!has_next) break;
#pragma unroll
        for (int a = 0; a < 2; ++a)
#pragma unroll
            for (int b = 0; b < 2; ++b)
#pragma unroll
                for (int m = 0; m < 4; ++m)
#pragma unroll
                    for (int n = 0; n < 2; ++n) acc[a][b][m][n] = (f32x4){0.f, 0.f, 0.f, 0.f};
        cur = nxt; cA = nA; cB = nB; ++ui;
        if constexpr (Epi::HAS_SS) { PG8_BAR; PG8_SSDMA(cur); }
        if (PG8_ALIGN_EPI) { if (wr == 1) PG8_BAR; }
    }
    PG8_WAIT_V(0);
    if (!PG8_ALIGN_EPI) { if (wr == 0) PG8_BAR; }
    PG8_BAR;
#undef PG8_SA
#undef PG8_SB
#undef PG8_STAGE
#undef PG8_LDA
#undef PG8_LDB
#undef PG8_MMA
#undef PG8_WAIT_V
#undef PG8_WAIT_L
#undef PG8_BAR
#undef PG8_SCHED
#undef PG8_SSDMA
}
}
using pg8::Unit;

typedef const f32x4 (&AccRef)[2][2][4][2];
__device__ __forceinline__ u32x4 pack8(f32x4 a, f32x4 b) { u32x4 w; w.x = pk_bf16(a[0], a[1]); w.y = pk_bf16(a[2], a[3]); w.z = pk_bf16(b[0], b[1]); w.w = pk_bf16(b[2], b[3]); return w; }

struct EpiSwiglu {      static constexpr bool HAS_SS = true; static constexpr int NAUX = 1;
    bf16_t* O; const float* ss; const float* bias; const LAS float* ssl;
    __device__ __forceinline__ const float* aux(int, const Unit& u, int lane) const { return bias + (size_t)(u.pm >> 5) * (2 * DFF) + u.pn * 256 + 4 * lane; }
    __device__ __forceinline__ void operator()(AccRef acc, const Unit& u, int wr, int wc, int fr, int fq) const {
        const int row0 = u.pm * 256 + wr * 64 + fr, col0 = u.pn * 128 + wc * 32 + 8 * fq;
        const LAS float* bl = ssl + 4096 + wc * 32 + 8 * fq;
        const f32x4 bg[2] = {*(const LAS f32x4*)bl, *(const LAS f32x4*)(bl + 4)}, bu[2] = {*(const LAS f32x4*)(bl + 128), *(const LAS f32x4*)(bl + 132)};
        float r8[2][4]; load_r8_lds(ssl, wr, fr, fq, r8);
#pragma unroll
        for (int ai = 0; ai < 2; ++ai)
#pragma unroll
            for (int m = 0; m < 4; ++m) {
                const int row = row0 + ai * 128 + m * 16; const float r = r8[ai][m];
                f32x4 h[2];
#pragma unroll
                for (int n = 0; n < 2; ++n) { const f32x4 gg = acc[ai][0][m][n] * r + bg[n], uu = acc[ai][1][m][n] * r + bu[n];
#pragma unroll
                    for (int j = 0; j < 4; ++j) h[n][j] = silu_f(gg[j]) * uu[j]; }
                *(u32x4*)(O + (size_t)row * DFF + col0) = pack8(h[0], h[1]);
            }
    }
};

template <bool GLU> struct EpiRes {         static constexpr bool HAS_SS = false; static constexpr int NAUX = 0; static constexpr int RB = GLU ? 2 : 4;
    const _Float16* baseh; float* out32; _Float16* outh;
    const float* gate; const float* colscale; const bf16_t* glu; const float* gsn; float* ssn; bf16_t* xs; float coef; int pad;
    __device__ __forceinline__ void operator()(f32x4 (&acc)[2][2][4][2], const Unit& u, int wr, int wc, int fr, int fq) const {
        typedef _Float16 h16x8 __attribute__((ext_vector_type(8)));
        const int row0 = u.pm * 256 + wr * 64 + fr, col0 = u.pn * 256 + wc * 32 + 8 * fq;
        const float* gv = gate + (size_t)(u.pm >> 5) * NMOD;
        const float* gsb = gsn ? gsn + (size_t)(u.pm >> 5) * D : nullptr;
        f32x4 gm[2][2], gsv[2][2];
        { f32x4 gq[8];
          const float* gp0 = gv + col0; const float* gp1 = (gsb ? gsb : gv) + col0;
          gld16<0>(gq[0], gp0); gld16<16>(gq[1], gp0); gld16<512>(gq[2], gp0); gld16<528>(gq[3], gp0);
          gld16<0>(gq[4], gp1); gld16<16>(gq[5], gp1); gld16<512>(gq[6], gp1); gld16<528>(gq[7], gp1); gwait8(gq);
#pragma unroll
          for (int bj = 0; bj < 2; ++bj)
#pragma unroll
            for (int n = 0; n < 2; ++n) { const int c = col0 + bj * 128 + 4 * n; f32x4 t = (gq[bj * 2 + n] + 1.0f) * coef;
                if (colscale) t = t * *(const f32x4*)(colscale + c); gm[bj][n] = t; gsv[bj][n] = gq[4 + bj * 2 + n]; } }
#pragma unroll
        for (int ai = 0; ai < 2; ++ai)
#pragma unroll
          for (int mp = 0; mp < 4 / RB; ++mp) {
            if constexpr (GLU) {
                f32x4 gq8[4];
#pragma unroll
                for (int mm = 0; mm < 2; ++mm) { const bf16_t* pg = glu + (size_t)(row0 + ai * 128 + (2 * mp + mm) * 16) * D + col0; gld16<0>(gq8[mm * 2], pg); gld16<256>(gq8[mm * 2 + 1], pg); }
                gwait4(gq8);
#pragma unroll
                for (int mm = 0; mm < 2; ++mm)
#pragma unroll
                    for (int bj = 0; bj < 2; ++bj) { const u32x4 gw4 = __builtin_bit_cast(u32x4, gq8[mm * 2 + bj]); const int m = 2 * mp + mm;
#pragma unroll
                        for (int n = 0; n < 2; ++n) { const unsigned w0 = n ? gw4.z : gw4.x, w1 = n ? gw4.w : gw4.y; const f32x4 gg = {bf_lo(w0), bf_hi(w0), bf_lo(w1), bf_hi(w1)};
#pragma unroll
                            for (int j = 0; j < 4; ++j) acc[ai][bj][m][n][j] = gg[j] * fast_sigmoid(acc[ai][bj][m][n][j]); } }
            }
            f32x4 hq[2 * RB];
#pragma unroll
            for (int mm = 0; mm < RB; ++mm) { const _Float16* pb = baseh + (size_t)(row0 + ai * 128 + (RB * mp + mm) * 16) * D + col0; gld16<0>(hq[mm * 2], pb); gld16<256>(hq[mm * 2 + 1], pb); }
            if constexpr (RB == 2) gwait4(hq); else gwait8(hq);
#pragma unroll
            for (int mm = 0; mm < RB; ++mm) { const int m = RB * mp + mm; const int row = row0 + ai * 128 + m * 16; const size_t ro = (size_t)row * D;
                float sq = 0.f;
#pragma unroll
                for (int bj = 0; bj < 2; ++bj) { f32x4 o[2];
                    const h16x8 hb8 = __builtin_bit_cast(h16x8, hq[mm * 2 + bj]);
#pragma unroll
                    for (int n = 0; n < 2; ++n) { const f32x4 bs = {(float)hb8[4 * n], (float)hb8[4 * n + 1], (float)hb8[4 * n + 2], (float)hb8[4 * n + 3]};
                        o[n] = bs + gm[bj][n] * acc[ai][bj][m][n];
                        sq += (o[n][0] * o[n][0] + o[n][1] * o[n][1]) + (o[n][2] * o[n][2] + o[n][3] * o[n][3]); }
                    const int c = col0 + bj * 128;
                    if (out32) { *(f32x4*)(out32 + ro + c) = o[0]; *(f32x4*)(out32 + ro + c + 4) = o[1]; }
                    else { const u32x2 h0 = __builtin_bit_cast(u32x2, __builtin_convertvector(o[0], h16x4)), h1 = __builtin_bit_cast(u32x2, __builtin_convertvector(o[1], h16x4));
                        u32x4 w; w.x = h0.x; w.y = h0.y; w.z = h1.x; w.w = h1.y; *(u32x4*)(outh + ro + c) = w; }
                    if (gsb) *(u32x4*)(xs + ro + c) = pack8(o[0] * gsv[bj][0], o[1] * gsv[bj][1]); }
                if (gsb) { sq += __shfl_xor(sq, 16); sq += __shfl_xor(sq, 32); if (fq == 0) ssn[((size_t)u.pn * M + row) * 4 + wc] = sq; } }
            asm volatile("" ::: "memory"); }
    }
};

struct EpiQKV {         static constexpr bool HAS_SS = true; static constexpr int NAUX = 2;
    bf16_t *Qo; float* logf; const float *qg, *kg, *bfv; const float* ss; const float* bias; const LAS float* ssl;
    __device__ __forceinline__ const float* aux(int k, const Unit& u, int lane) const {
        return k == 0 ? bias + (size_t)(u.pm >> 5) * NFOX + u.pn * 256 + 4 * lane : (lane < 16 ? qg + 4 * lane : kg + 4 * (lane & 15)); }
    __device__ __forceinline__ void operator()(AccRef acc, const Unit& u, int wr, int wc, int fr, int fq) const {
        const int row0 = u.pm * 256 + wr * 64 + fr;
        float r8[2][4]; load_r8_lds(ssl, wr, fr, fq, r8);
        f32x4 bgv[8];
        { const LAS float* bl = ssl + 4096 + wc * 32 + 8 * fq; const LAS float* gl = ssl + 4096 + 256 + (u.pn < 4 ? 0 : 64) + 8 * fq;
          bgv[0] = *(const LAS f32x4*)bl; bgv[1] = *(const LAS f32x4*)(bl + 4); bgv[2] = *(const LAS f32x4*)(bl + 128); bgv[3] = *(const LAS f32x4*)(bl + 132);
          bgv[4] = *(const LAS f32x4*)gl; bgv[5] = *(const LAS f32x4*)(gl + 4); bgv[6] = *(const LAS f32x4*)(gl + 32); bgv[7] = *(const LAS f32x4*)(gl + 36); }
        if (u.pn < 12) {
            const int which = u.pn >> 2, head = 4 * (u.pn & 3) + wc;
            bf16_t* dst = Qo + (size_t)which * ((WS_R3 - WS_R2) / 2);
            const float gs = which == 0 ? QSCALE : 1.0f;
#pragma unroll
            for (int ai = 0; ai < 2; ++ai)
#pragma unroll
                for (int m = 0; m < 4; ++m) {
                    const int row = row0 + ai * 128 + m * 16; const float r = r8[ai][m];
                    f32x4 v[2][2];
#pragma unroll
                    for (int bj = 0; bj < 2; ++bj)
#pragma unroll
                        for (int n = 0; n < 2; ++n) v[bj][n] = acc[ai][bj][m][n] * r + bgv[bj * 2 + n];
                    float rinv = 1.0f;
                    if (which < 2) { float sq = 0.f;
#pragma unroll
                        for (int bj = 0; bj < 2; ++bj)
#pragma unroll
                            for (int n = 0; n < 2; ++n) { const f32x4 a = v[bj][n]; sq += (a[0] * a[0] + a[1] * a[1]) + (a[2] * a[2] + a[3] * a[3]); }
                        sq += __shfl_xor(sq, 16); sq += __shfl_xor(sq, 32);
                        rinv = rsqrtf(sq * (1.0f / 64.0f) + EPS) * gs; }
                    bf16_t* rp = dst + (size_t)row * D + head * 64 + 8 * fq;
#pragma unroll
                    for (int bj = 0; bj < 2; ++bj) {
                        f32x4 g0 = {1.f, 1.f, 1.f, 1.f}, g1 = g0;
                        if (which < 2) { g0 = bgv[4 + bj * 2]; g1 = bgv[5 + bj * 2]; }
                        *(u32x4*)(rp + 32 * bj) = pack8(v[bj][0] * rinv * g0, v[bj][1] * rinv * g1); }
                    asm volatile("" ::: "memory");
                }
        } else if (wc == 0 && fq < 2) {
#pragma unroll
            for (int ai = 0; ai < 2; ++ai)
#pragma unroll
                for (int m = 0; m < 4; ++m) { const int row = row0 + ai * 128 + m * 16; const float r = r8[ai][m];
#pragma unroll
                    for (int n = 0; n < 2; ++n) { const f32x4 bb = *(const f32x4*)(bfv + 8 * fq + 4 * n) + bgv[n]; f32x4 v = acc[ai][0][m][n] * r + bb;
#pragma unroll
                        for (int j = 0; j < 4; ++j) logf[((size_t)(row >> 13) * 16 + 8 * fq + 4 * n + j) * SEQ + (row & (SEQ - 1))] = log_sigmoid(v[j]); } }
        }
    }
};

struct EpiConvIn {      static constexpr bool HAS_SS = true; static constexpr int NAUX = 1;
    bf16_t *CZ, *BG; const float* ss; const float* bias; const LAS float* ssl;
    __device__ __forceinline__ const float* aux(int, const Unit& u, int lane) const { return bias + (size_t)(u.pm >> 5) * (3 * D) + u.pn * 256 + 4 * lane; }
    __device__ __forceinline__ void operator()(AccRef acc, const Unit& u, int wr, int wc, int fr, int fq) const {
        const int row0 = u.pm * 256 + wr * 64 + fr;
        const LAS float* bl = ssl + 4096 + wc * 32 + 8 * fq;
        const f32x4 bv[2][2] = {{*(const LAS f32x4*)bl, *(const LAS f32x4*)(bl + 4)}, {*(const LAS f32x4*)(bl + 128), *(const LAS f32x4*)(bl + 132)}};
        float r8[2][4]; load_r8_lds(ssl, wr, fr, fq, r8);
        if (u.pn < 8) {
#pragma unroll
            for (int ai = 0; ai < 2; ++ai)
#pragma unroll
                for (int m = 0; m < 4; ++m) { const int row = row0 + ai * 128 + m * 16; const float r = r8[ai][m];
                    *(u32x4*)(CZ + (size_t)row * D + u.pn * 128 + wc * 32 + 8 * fq) = pack8((acc[ai][0][m][0] * r + bv[0][0]) * (acc[ai][1][m][0] * r + bv[1][0]), (acc[ai][0][m][1] * r + bv[0][1]) * (acc[ai][1][m][1] * r + bv[1][1])); }
        } else {
#pragma unroll
            for (int ai = 0; ai < 2; ++ai)
#pragma unroll
                for (int m = 0; m < 4; ++m) { const int row = row0 + ai * 128 + m * 16; const float r = r8[ai][m];
#pragma unroll
                    for (int bj = 0; bj < 2; ++bj)
                        *(u32x4*)(BG + (size_t)row * D + (u.pn - 8) * 256 + bj * 128 + wc * 32 + 8 * fq) = pack8(acc[ai][bj][m][0] * r + bv[bj][0], acc[ai][bj][m][1] * r + bv[bj][1]); }
        }
    }
};

__device__ __forceinline__ int colmap(int type, int r) {
    const int pn = r >> 8, c = r & 255;
    if (type == 1) return (c >> 7) * DFF + pn * 128 + (c & 127);
    if (type == 2) return r < 3072 ? pn * 256 + ((c >> 5) & 3) * 64 + (c >> 7) * 32 + (c & 31) : r;
    if (type == 3) return pn < 8 ? 1024 + (c >> 7) * 1024 + pn * 128 + (c & 127) : (pn - 8) * 256 + c;
    return r;
}
__device__ __forceinline__ void transpose_item(const float* W, int ld, int K, bf16_t* WT, int type, int nvalid, LAS float* scr, int kb, int nb, int lane) {
    const int k0 = 64 * kb, n0 = 32 * nb; const int sc = colmap(type, n0) + (lane & 31); const bool ok = sc < nvalid;
    float wv[32];
#pragma unroll
    for (int i = 0; i < 32; ++i) { const int kk = 2 * i + (lane >> 5); wv[i] = ok ? W[(size_t)(k0 + kk) * ld + sc] : 0.f; }
#pragma unroll
    for (int i = 0; i < 32; ++i) { const int kk = 2 * i + (lane >> 5); scr[kk * 33 + (lane & 31)] = wv[i]; }
    asm volatile("s_waitcnt lgkmcnt(0)" ::: "memory");
    const int c = lane & 7;
#pragma unroll
    for (int j = 0; j < 4; ++j) { const int n = (lane >> 3) + 8 * j; const LAS float* s = scr + (8 * c) * 33 + n;
        u32x4 o; o.x = pk_bf16(s[0 * 33], s[1 * 33]); o.y = pk_bf16(s[2 * 33], s[3 * 33]); o.z = pk_bf16(s[4 * 33], s[5 * 33]); o.w = pk_bf16(s[6 * 33], s[7 * 33]);
        *(u32x4*)(WT + (size_t)(n0 + n) * K + k0 + 8 * c) = o; }
    asm volatile("s_waitcnt lgkmcnt(0)" ::: "memory");
}

__device__ __forceinline__ void prologue_phase(KP kp, LAS unsigned char* lds, int rep) {
    const int tid = opaque_tid(), lane = tid & 63, wid = tid >> 6, G = gridDim.x;
    unsigned char* ws = kp->ws;
    {
        LAS float* condS = (LAS float*)lds; LAS float* red = (LAS float*)(lds + 16384);
        const float* cin = kp->in[1];
        for (int i = tid; i < 4096; i += NTHREADS) condS[i] = silu_f(cin[i]);
        __syncthreads();
        float* mod = (float*)(ws + WS_MOD);
        const float* ada_w = kp->in[2]; const float* ada_b = kp->in[3];
        for (int it = blockIdx.x; it < 288; it += G) {
            const int l = it / 72, col0 = (it % 72) * 128, cq = tid & 31, kc = tid >> 5;
            f32x4 a0 = {0, 0, 0, 0}, a1 = a0, a2 = a0, a3 = a0;
            const float* wp = ada_w + ((size_t)l * D + kc * 64) * NMOD + col0 + cq * 4;
#pragma unroll 16
            for (int i = 0; i < 64; ++i) { const f32x4 w = *(const f32x4*)(wp + (size_t)i * NMOD); const int k = kc * 64 + i;
                a0 += w * condS[k]; a1 += w * condS[1024 + k]; a2 += w * condS[2048 + k]; a3 += w * condS[3072 + k]; }
            *(LAS f32x4*)(red + (kc * 4 + 0) * 128 + cq * 4) = a0; *(LAS f32x4*)(red + (kc * 4 + 1) * 128 + cq * 4) = a1;
            *(LAS f32x4*)(red + (kc * 4 + 2) * 128 + cq * 4) = a2; *(LAS f32x4*)(red + (kc * 4 + 3) * 128 + cq * 4) = a3;
            __syncthreads();
            { const int b = tid >> 7, col = tid & 127; float s = ada_b[l * NMOD + col0 + col];
#pragma unroll
              for (int k2 = 0; k2 < 16; ++k2) s += red[(k2 * 4 + b) * 128 + col];
              mod[(size_t)(l * 4 + b) * NMOD + col0 + col] = s; }
            __syncthreads();
        }
    }
    __syncthreads();
    {
        LAS float* scr = (LAS float*)(lds + wid * 8448);
        constexpr int I_FIN = 16 * 176, I_FOUT = 44 * 32, I_FOXIN = 16 * 104, I_SQ = 16 * 32, I_CONVIN = 16 * 96, I_POOL = 4 * 8;
        constexpr int NITEMS = 8 * I_FIN + 8 * I_FOUT + I_FOXIN + 3 * I_SQ + I_CONVIN + I_SQ * 0 + 4 * I_POOL;
        unsigned* steal = (unsigned*)(ws + WS_BAR) + 3584 + 64 * rep;
        for (;;) {
        unsigned base8 = 0u; if (lane == 0) base8 = atomicAdd(steal, 8u);
        base8 = (unsigned)__builtin_amdgcn_readfirstlane((int)base8);
        if (base8 >= (unsigned)NITEMS) break;
        for (int it = (int)base8; it < (int)base8 + 8 && it < NITEMS; ++it) {
            int r = it; const float* src; bf16_t* dst; int K, ld, nd, type = 0, nvalid;
            if (r < 8 * I_FIN) { const int j = r / I_FIN; r %= I_FIN; src = kp->in[5] + (size_t)j * D * 2 * DFF; dst = (bf16_t*)(ws + WS_WFFIN) + (size_t)j * 2 * DFF * D; K = D; ld = 2 * DFF; nd = 2 * DFF; type = 1; nvalid = ld; }
            else if ((r -= 8 * I_FIN) < 8 * I_FOUT) { const int j = r / I_FOUT; r %= I_FOUT; src = kp->in[6] + (size_t)j * DFF * D; dst = (bf16_t*)(ws + WS_WFFOUT) + (size_t)j * D * DFF; K = DFF; ld = D; nd = D; nvalid = ld; }
            else if ((r -= 8 * I_FOUT) < I_FOXIN) { src = kp->in[9]; dst = (bf16_t*)(ws + WS_WFOXIN); K = D; ld = 3 * D + 16; nd = NFOX; type = 2; nvalid = ld; }
            else if ((r -= I_FOXIN) < I_SQ) { src = kp->in[13]; dst = (bf16_t*)(ws + WS_WFOXO); K = D; ld = D; nd = D; nvalid = ld; }
            else if ((r -= I_SQ) < I_SQ) { src = kp->in[22]; dst = (bf16_t*)(ws + WS_WGLU); K = D; ld = D; nd = D; nvalid = ld; }
            else if ((r -= I_SQ) < I_CONVIN) { src = kp->in[23]; dst = (bf16_t*)(ws + WS_WCONVIN); K = D; ld = 3 * D; nd = 3 * D; type = 3; nvalid = ld; }
            else if ((r -= I_CONVIN) < I_SQ) { src = kp->in[25]; dst = (bf16_t*)(ws + WS_WCONVOUT); K = D; ld = D; nd = D; nvalid = ld; }
            else { r -= I_SQ; const int j = r / I_POOL; r %= I_POOL; src = kp->in[7] + (size_t)j * 256 * 256; dst = (bf16_t*)(ws + WS_WPOOL) + (size_t)j * 256 * 256; K = 256; ld = 256; nd = 256; nvalid = ld; }
            const int nblk = nd / 32;
            transpose_item(src, ld, K, dst, type, nvalid, scr, r / nblk, r % nblk, lane);
        }
        }
    }
}

__device__ __forceinline__ void load8(const bf16_t* p, float (&f)[8]) { const u32x4 w = *(const u32x4*)p; f[0] = bf_lo(w.x); f[1] = bf_hi(w.x); f[2] = bf_lo(w.y); f[3] = bf_hi(w.y); f[4] = bf_lo(w.z); f[5] = bf_hi(w.z); f[6] = bf_lo(w.w); f[7] = bf_hi(w.w); }
__device__ __forceinline__ void store8(bf16_t* p, const float (&f)[8]) { u32x4 w; w.x = pk_bf16(f[0], f[1]); w.y = pk_bf16(f[2], f[3]); w.z = pk_bf16(f[4], f[5]); w.w = pk_bf16(f[6], f[7]); *(u32x4*)p = w; }
__device__ __forceinline__ void norm0_phase(KP kp) {
    const int tid = opaque_tid(), lane = tid & 63, wid = tid >> 6;
    const int gw = blockIdx.x * NWAVES + wid, NGW = gridDim.x * NWAVES;
    unsigned char* ws = kp->ws;
    const float* mod = (const float*)(ws + WS_MOD); const float* gain = kp->in[4]; const float* x = kp->in[0];
    bf16_t* xs = (bf16_t*)(ws + WS_HB); float* ss = (float*)(ws + WS_SS); _Float16* xh = (_Float16*)(ws + WS_XH);
    for (int row0 = gw; row0 < M; row0 += 2 * NGW) {
        const int rowB = (row0 + NGW < M) ? row0 + NGW : row0;
        f32x4 v[2][4]; float sq[2] = {0.f, 0.f};
#pragma unroll
        for (int q = 0; q < 2; ++q) { const f32x4* xr = (const f32x4*)(x + (size_t)(q ? rowB : row0) * D) + lane;
#pragma unroll
            for (int j = 0; j < 4; ++j) v[q][j] = xr[64 * j]; }
#pragma unroll
        for (int q = 0; q < 2; ++q) {
#pragma unroll
            for (int j = 0; j < 4; ++j) sq[q] += (v[q][j][0] * v[q][j][0] + v[q][j][1] * v[q][j][1]) + (v[q][j][2] * v[q][j][2] + v[q][j][3] * v[q][j][3]);
            sq[q] = wave_sum(sq[q]); }
#pragma unroll
        for (int q = 0; q < 2; ++q) { const int row = q ? rowB : row0; if (q && rowB == row0) break;
            const float* scale = mod + (size_t)(row >> 13) * NMOD + D;
            if (lane < 16) ss[((size_t)(lane >> 2) * M + row) * 4 + (lane & 3)] = lane == 0 ? sq[q] : 0.f;
            u32x2* o8 = (u32x2*)(xs + (size_t)row * D) + lane; u32x2* h8 = (u32x2*)(xh + (size_t)row * D) + lane;
#pragma unroll
            for (int j = 0; j < 4; ++j) { const int c = 4 * (lane + 64 * j);
                const f32x4 o = v[q][j] * *(const f32x4*)(gain + c) * (*(const f32x4*)(scale + c) + 1.0f);
                u32x2 w; w.x = pk_bf16(o[0], o[1]); w.y = pk_bf16(o[2], o[3]); o8[64 * j] = w;
                h8[64 * j] = __builtin_bit_cast(u32x2, __builtin_convertvector(v[q][j], h16x4)); } }
    }
    { float* gs = (float*)(ws + WS_GS);
      for (int i = blockIdx.x * NTHREADS + tid; i < 12 * 4 * D; i += gridDim.x * NTHREADS) { const int c = i & (D - 1), b = (i >> 10) & 3, sidx = i >> 12, l = sidx / 3, sub = sidx % 3;
          gs[i] = gain[sidx * D + c] * (1.0f + mod[(size_t)(l * 4 + b) * NMOD + (sub * 3 + 1) * D + c]); } }
    { float* bv = (float*)(ws + WS_BIASV);
      constexpr int R_FFN = 2 * DFF, R_ALL = 8 * R_FFN + NFOX + 3 * D;
      for (int rr0 = gw; rr0 < R_ALL; rr0 += 2 * NGW) {
          const bf16_t* wrow[2]; const float* sh[2]; float* dst[2]; int nstr[2]; float w[2][16];
#pragma unroll
          for (int q = 0; q < 2; ++q) { const int rr = (q && rr0 + NGW < R_ALL) ? rr0 + NGW : rr0;
              if (rr < 8 * R_FFN) { const int j = rr / R_FFN, n = rr % R_FFN, l = j >> 1, sub = (j & 1) ? 2 : 0;
                  wrow[q] = (const bf16_t*)(ws + WS_WFFIN) + ((size_t)j * R_FFN + n) * D; sh[q] = mod + (size_t)l * 4 * NMOD + (sub * 3) * D; dst[q] = bv + (size_t)j * BV_FFN + n; nstr[q] = R_FFN; }
              else if (rr < 8 * R_FFN + NFOX) { const int n = rr - 8 * R_FFN; wrow[q] = (const bf16_t*)(ws + WS_WFOXIN) + (size_t)n * D; sh[q] = mod + (size_t)1 * 4 * NMOD + 3 * D; dst[q] = bv + BV_QKV_OFF + n; nstr[q] = NFOX; }
              else { const int n = rr - 8 * R_FFN - NFOX; wrow[q] = (const bf16_t*)(ws + WS_WCONVIN) + (size_t)n * D; sh[q] = mod + (size_t)3 * 4 * NMOD + 3 * D; dst[q] = bv + BV_CONV_OFF + n; nstr[q] = 3 * D; }
              float f[8]; load8(wrow[q] + 16 * lane, f);
#pragma unroll
              for (int j = 0; j < 8; ++j) w[q][j] = f[j];
              load8(wrow[q] + 16 * lane + 8, f);
#pragma unroll
              for (int j = 0; j < 8; ++j) w[q][8 + j] = f[j]; }
#pragma unroll
          for (int q = 0; q < 2; ++q) { if (q && rr0 + NGW >= R_ALL) break;
#pragma unroll
              for (int b = 0; b < 4; ++b) { const float* sp = sh[q] + (size_t)b * NMOD + 16 * lane; float a = 0.f;
#pragma unroll
                  for (int q4 = 0; q4 < 4; ++q4) { const f32x4 sv = *(const f32x4*)(sp + 4 * q4); a += (w[q][4 * q4] * sv[0] + w[q][4 * q4 + 1] * sv[1]) + (w[q][4 * q4 + 2] * sv[2] + w[q][4 * q4 + 3] * sv[3]); }
                  a = wave_sum(a); if (lane == 0) dst[q][(size_t)b * nstr[q]] = a; } }
      } }
}

__device__ __forceinline__ void load8n(const bf16_t* p, const float* ssp, int row, const float (&sh)[8], float (&f)[8]) { load8(p, f); const float r = rs_row(ssp, row);
#pragma unroll
    for (int j = 0; j < 8; ++j) f[j] = f[j] * r + sh[j]; }
__device__ __forceinline__ void pool_phase(const bf16_t* xs, const float* ss, const float* shiftl, bf16_t* pooled) {
    const int tid = opaque_tid();
    for (int wi = blockIdx.x; wi < 512; wi += gridDim.x) {
        const int rb = wi * 4 + (tid >> 7), o = tid & 127, w = 2 << (o >> 5);
        const int row0 = rb * 16, t0 = row0 & (SEQ - 1);
        const bf16_t* hp = xs + (size_t)row0 * D + o * 8;
        float sh[8]; { const float* shp = shiftl + (size_t)(row0 >> 13) * NMOD + o * 8;
#pragma unroll
            for (int j = 0; j < 8; ++j) sh[j] = shp[j]; }
        float sum[8], cur[8], old[8];
#pragma unroll
        for (int j = 0; j < 8; ++j) sum[j] = 0.f;
        for (int k = 1; k < w; ++k) if (t0 - k >= 0) { load8n(hp - (size_t)k * D, ss, row0 - k, sh, old);
#pragma unroll
            for (int j = 0; j < 8; ++j) sum[j] += old[j]; }
        for (int tt = 0; tt < 16; ++tt) {
            const int t = t0 + tt; load8n(hp + (size_t)tt * D, ss, row0 + tt, sh, cur);
            const float inv = 1.0f / (float)((t + 1) < w ? (t + 1) : w);
            float ov[8];
#pragma unroll
            for (int j = 0; j < 8; ++j) { sum[j] += cur[j]; ov[j] = sum[j] * inv - cur[j]; }
            store8(pooled + (size_t)(row0 + tt) * D + o * 8, ov);
            if (t - w + 1 >= 0) { load8n(hp + (size_t)(tt - w + 1) * D, ss, row0 + tt - w + 1, sh, old);
#pragma unroll
                for (int j = 0; j < 8; ++j) sum[j] -= old[j]; }
        }
    }
}

__device__ __forceinline__ void conv_phase(const bf16_t* cz, const bf16_t* bg, const float* cw, bf16_t* a2) {
    const int tid = opaque_tid(), o = tid & 127;
    float w0[8], w1[8], w2[8];
#pragma unroll
    for (int j = 0; j < 8; ++j) { w0[j] = cw[o * 8 + j]; w1[j] = cw[D + o * 8 + j]; w2[j] = cw[2 * D + o * 8 + j]; }
    for (int wi = blockIdx.x; wi < M / 4; wi += gridDim.x) {
        const int row = wi * 4 + (tid >> 7), t = row & (SEQ - 1);
        const size_t off = (size_t)row * D + o * 8;
        float x0[8], x1[8], x2[8], b[8], ov[8];
        load8(cz + off, x2); load8(bg + off, b);
        if (t >= 1) load8(cz + off - D, x1); else {
#pragma unroll
            for (int j = 0; j < 8; ++j) x1[j] = 0.f; }
        if (t >= 2) load8(cz + off - 2 * D, x0); else {
#pragma unroll
            for (int j = 0; j < 8; ++j) x0[j] = 0.f; }
#pragma unroll
        for (int j = 0; j < 8; ++j) ov[j] = b[j] * (w0[j] * x0[j] + w1[j] * x1[j] + w2[j] * x2[j]);
        store8(a2 + off, ov);
    }
}

__device__ __forceinline__ void cumsum_phase(const float* logf, float* biasK, LAS unsigned char* lds) {
    const int tid = opaque_tid(), lane = tid & 63, wid = tid >> 6;
    LAS float* wtot = (LAS float*)lds;
    for (int it = blockIdx.x; it < 64; it += gridDim.x) {
        const int b = it >> 4, h = it & 15;
        const size_t base = ((size_t)b * SEQ + tid * 16) * 16 + h;
        float v[16];
#pragma unroll
        for (int i = 0; i < 16; ++i) v[i] = logf[base + (size_t)i * 16];
#pragma unroll
        for (int i = 1; i < 16; ++i) v[i] += v[i - 1];
        float inc = v[15];
#pragma unroll
        for (int o = 1; o < 64; o <<= 1) { const float t = __shfl_up(inc, o); if (lane >= o) inc += t; }
        if (lane == 63) wtot[wid] = inc;
        __syncthreads();
        float off = inc - v[15];
        for (int w2 = 0; w2 < wid; ++w2) off += wtot[w2];
#pragma unroll
        for (int i = 0; i < 16; ++i) biasK[base + (size_t)i * 16] = -LOG2E * (v[i] + off);
        __syncthreads();
    }
}

__device__ __forceinline__ int crow(int r, int hi) { return (r & 3) + 8 * (r >> 2) + 4 * hi; }
__device__ __forceinline__ void att_tile(const LAS unsigned char* bb, const bf16x8 (&qr)[4], int t, int wq0, int qloc, int r32, int hi, float& mrun, float& lrun, f32x16 (&oT)[2]) {
    constexpr int ROWB = 144, KT = 64 * ROWB;
    const LAS float* bias = (const LAS float*)(bb + 2 * KT);
    f32x16 p0, p1;
#pragma unroll
    for (int g4 = 0; g4 < 4; ++g4) { const f32x4 b0 = *(const LAS f32x4*)(bias + 8 * g4 + 4 * hi), b1 = *(const LAS f32x4*)(bias + 32 + 8 * g4 + 4 * hi);
#pragma unroll
        for (int j = 0; j < 4; ++j) { p0[4 * g4 + j] = b0[j]; p1[4 * g4 + j] = b1[j]; } }
#pragma unroll
    for (int d0 = 0; d0 < 4; ++d0) {
        const bf16x8 k0 = *(const LAS bf16x8*)(bb + r32 * ROWB + d0 * 32 + hi * 16);
        const bf16x8 k1 = *(const LAS bf16x8*)(bb + (32 + r32) * ROWB + d0 * 32 + hi * 16);
        p0 = __builtin_amdgcn_mfma_f32_32x32x16_bf16(k0, qr[d0], p0, 0, 0, 0);
        p1 = __builtin_amdgcn_mfma_f32_32x32x16_bf16(k1, qr[d0], p1, 0, 0, 0);
    }
    if (64 * t + 63 > wq0) {
#pragma unroll
        for (int r = 0; r < 16; ++r) { const int kv = 64 * t + crow(r, hi); if (kv > qloc) p0[r] = -1e30f; if (kv + 32 > qloc) p1[r] = -1e30f; }
    }
    float mt = fmaxf(p0[0], p1[0]);
#pragma unroll
    for (int r = 1; r < 16; ++r) mt = fmaxf(mt, fmaxf(p0[r], p1[r]));
    mt = fmaxf(mt, __shfl_xor(mt, 32));
    const float mnew = fmaxf(mrun, mt);
    const float alpha = __builtin_amdgcn_exp2f(mrun - mnew);
    mrun = mnew;
    float ls = 0.f;
#pragma unroll
    for (int r = 0; r < 16; ++r) { p0[r] = __builtin_amdgcn_exp2f(p0[r] - mnew); p1[r] = __builtin_amdgcn_exp2f(p1[r] - mnew); ls += p0[r] + p1[r]; }
    lrun = lrun * alpha + ls;
#pragma unroll
    for (int r = 0; r < 16; ++r) { oT[0][r] *= alpha; oT[1][r] *= alpha; }
    bf16x8 pf[4];
    { u32x4 w;
      w.x = pk_bf16(p0[0], p0[1]); w.y = pk_bf16(p0[2], p0[3]); w.z = pk_bf16(p0[4], p0[5]); w.w = pk_bf16(p0[6], p0[7]); pf[0] = __builtin_bit_cast(bf16x8, w);
      w.x = pk_bf16(p0[8], p0[9]); w.y = pk_bf16(p0[10], p0[11]); w.z = pk_bf16(p0[12], p0[13]); w.w = pk_bf16(p0[14], p0[15]); pf[1] = __builtin_bit_cast(bf16x8, w);
      w.x = pk_bf16(p1[0], p1[1]); w.y = pk_bf16(p1[2], p1[3]); w.z = pk_bf16(p1[4], p1[5]); w.w = pk_bf16(p1[6], p1[7]); pf[2] = __builtin_bit_cast(bf16x8, w);
      w.x = pk_bf16(p1[8], p1[9]); w.y = pk_bf16(p1[10], p1[11]); w.z = pk_bf16(p1[12], p1[13]); w.w = pk_bf16(p1[14], p1[15]); pf[3] = __builtin_bit_cast(bf16x8, w); }
    const LAS unsigned char* vt = bb + KT;
#pragma unroll
    for (int db = 0; db < 2; ++db)
#pragma unroll
        for (int cc = 0; cc < 4; ++cc) {
            const bf16x8 vf = *(const LAS bf16x8*)(vt + (32 * db + r32) * ROWB + cc * 32 + hi * 16);
            oT[db] = __builtin_amdgcn_mfma_f32_32x32x16_bf16(vf, pf[cc], oT[db], 0, 0, 0);
        }
}
__device__ __forceinline__ void attn_phase(LAS unsigned char* lds, const bf16_t* Q, const bf16_t* Kg, const bf16_t* Vg, bf16_t* O, const float* logf, const float* qg, const float* kg) {
    const int tid = opaque_tid(), lane = tid & 63, wid = __builtin_amdgcn_readfirstlane(tid >> 6), r32 = lane & 31, hi = lane >> 5;
    const int G = gridDim.x, c = blockIdx.x;
    constexpr int ROWB = 144, KT = 64 * ROWB, BUF = 2 * KT + 256;
    const int kvr = tid >> 3, ch = tid & 7;
    const int slot = (kvr & ~15) | (kvr & 3) | ((kvr & 4) << 1) | ((kvr & 8) >> 1);
    float SB; { float a = fabsf(qg[lane]), b2 = fabsf(kg[lane]);
#pragma unroll
        for (int o = 1; o < 64; o <<= 1) { a = fmaxf(a, __shfl_xor(a, o)); b2 = fmaxf(b2, __shfl_xor(b2, o)); }
        SB = 64.0f * a * b2 * QSCALE * 1.02f; }
    for (int i = 0; i * G < 1024; ++i) {
        const int pidx = i * G + ((i & 1) ? (G - 1 - c) : c);
        if (pidx >= 1024) continue;
        const int qb = 15 - (pidx >> 6), bh = ((pidx & 63) + 9 * (pidx >> 8)) & 63, b = bh >> 4, h = bh & 15;
        const int q0 = qb * 512, NT = 8 * qb + 8;
        const size_t rowbase = (size_t)b * SEQ;
        bf16x8 qr[2][4];
#pragma unroll
        for (int sb = 0; sb < 2; ++sb)
#pragma unroll
            for (int d0 = 0; d0 < 4; ++d0) qr[sb][d0] = *(const bf16x8*)(Q + (rowbase + q0 + 256 * sb + wid * 32 + r32) * D + h * 64 + d0 * 16 + hi * 8);
        LAS float* wt = (LAS float*)(lds + 2 * BUF + 64); LAS float* bL = (LAS float*)(lds + 2 * BUF + 128);
        { const f32x4* lf = (const f32x4*)(logf + ((size_t)b * 16 + h) * SEQ + tid * 16);
          const f32x4 l0 = lf[0], l1 = lf[1], l2 = lf[2], l3 = lf[3];
          float v[16] = {l0[0], l0[1], l0[2], l0[3], l1[0], l1[1], l1[2], l1[3], l2[0], l2[1], l2[2], l2[3], l3[0], l3[1], l3[2], l3[3]};
#pragma unroll
          for (int e = 1; e < 16; ++e) v[e] += v[e - 1];
          float inc = v[15];
#pragma unroll
          for (int o = 1; o < 64; o <<= 1) { const float tt = __shfl_up(inc, o); if (lane >= o) inc += tt; }
          if (lane == 63) wt[wid] = inc;
          __syncthreads();
          float off = inc - v[15];
          for (int w2 = 0; w2 < wid; ++w2) off += wt[w2];
#pragma unroll
          for (int e = 0; e < 16; ++e) bL[tid * 16 + e] = -LOG2E * (v[e] + off);
          __syncthreads(); }
        const float ref = bL[q0 + 511];
        const bf16_t* kp = Kg + (rowbase + kvr) * D + h * 64 + ch * 8;
        const bf16_t* vp = Vg + (rowbase + kvr) * D + h * 64 + ch * 8;
        const LAS float* bp = bL + (tid & 63);
        u32x4 kreg = *(const u32x4*)(kp + (size_t)(NT - 1) * 64 * D), vreg = *(const u32x4*)(vp + (size_t)(NT - 1) * 64 * D); float breg = (tid < 64) ? bp[(NT - 1) * 64] - ref : 0.f;
#define ATT_WRITE(bufi) do { LAS unsigned char* bb_ = lds + (bufi) * BUF; \
            *(LAS u32x4*)(bb_ + kvr * ROWB + ch * 16) = kreg; \
            LAS bf16_t* vt_ = (LAS bf16_t*)(bb_ + KT) + (ch * 8) * (ROWB / 2) + slot; \
            vt_[0 * (ROWB / 2)] = (bf16_t)(vreg.x & 0xffff); vt_[1 * (ROWB / 2)] = (bf16_t)(vreg.x >> 16); \
            vt_[2 * (ROWB / 2)] = (bf16_t)(vreg.y & 0xffff); vt_[3 * (ROWB / 2)] = (bf16_t)(vreg.y >> 16); \
            vt_[4 * (ROWB / 2)] = (bf16_t)(vreg.z & 0xffff); vt_[5 * (ROWB / 2)] = (bf16_t)(vreg.z >> 16); \
            vt_[6 * (ROWB / 2)] = (bf16_t)(vreg.w & 0xffff); vt_[7 * (ROWB / 2)] = (bf16_t)(vreg.w >> 16); \
            if (tid < 64) ((LAS float*)(bb_ + 2 * KT))[tid] = breg; } while (0)
        ATT_WRITE((NT - 1) & 1);
        __syncthreads();
        float mrun[2] = {-1e30f, -1e30f}, lrun[2] = {0.f, 0.f};
        f32x16 oT[2][2];
#pragma unroll
        for (int r = 0; r < 16; ++r) { oT[0][0][r] = 0.f; oT[0][1][r] = 0.f; oT[1][0][r] = 0.f; oT[1][1][r] = 0.f; }
        for (int t = NT - 1; t >= 0; --t) {
            const int cur = t & 1;
            if (t > 0) { kreg = *(const u32x4*)(kp + (size_t)(t - 1) * 64 * D); vreg = *(const u32x4*)(vp + (size_t)(t - 1) * 64 * D); if (tid < 64) breg = bp[(t - 1) * 64] - ref; }
            const LAS unsigned char* bb = lds + cur * BUF;
            const float bmax = ((const LAS float*)(bb + 2 * KT))[63];
            int dead = 1;
#pragma unroll
            for (int sb = 0; sb < 2; ++sb) {
                const int wq0 = q0 + 256 * sb + wid * 32;
                const int dsb = __all((SB + bmax - mrun[sb]) < -150.0f);
                if (64 * t <= wq0 + 31) {
                    if (!dsb) att_tile(bb, qr[sb], t, wq0, wq0 + r32, r32, hi, mrun[sb], lrun[sb], oT[sb]);
                    dead &= dsb;
                } else dead = 0;
            }
            if (t > 0) ATT_WRITE(cur ^ 1);
            { LAS int* fl = (LAS int*)(lds + 2 * BUF) + cur * 8;
              if (lane == 0) fl[wid] = dead;
              __syncthreads();
              const LAS u32x4* fv = (const LAS u32x4*)fl; const u32x4 f0 = fv[0], f1 = fv[1];
              if ((f0.x & f0.y & f0.z & f0.w & f1.x & f1.y & f1.z & f1.w) != 0u) break; }
        }
#undef ATT_WRITE
#pragma unroll
        for (int sb = 0; sb < 2; ++sb) {
            const float ltot = lrun[sb] + __shfl_xor(lrun[sb], 32);
            const float rl = 1.0f / ltot;
            bf16_t* op = O + (rowbase + q0 + 256 * sb + wid * 32 + r32) * D + h * 64;
#pragma unroll
            for (int db = 0; db < 2; ++db)
#pragma unroll
                for (int g4 = 0; g4 < 4; ++g4) { u32x2 w; w.x = pk_bf16(oT[sb][db][4 * g4] * rl, oT[sb][db][4 * g4 + 1] * rl); w.y = pk_bf16(oT[sb][db][4 * g4 + 2] * rl, oT[sb][db][4 * g4 + 3] * rl);
                    *(u32x2*)(op + 32 * db + 8 * g4 + 4 * hi) = w; }
        }
    }
}

template <bool PASS_B>
__device__ __forceinline__ void s5_phase(KP kp, LAS unsigned char* lds, const bf16_t* hb, const float* ss, const float* shiftl, f32x2* Ebuf, bf16_t* gout) {
    const int tid = opaque_tid(), lane = tid & 63, wid = __builtin_amdgcn_readfirstlane(tid >> 6), l31 = lane & 31, hi = lane >> 5;
    constexpr int XROW = 272;
    LAS unsigned char* xS = lds + wid * (32 * XROW);
    const float *lam_re = kp->in[14], *lam_im = kp->in[15], *log_dt = kp->in[16], *b_re = kp->in[17], *b_im = kp->in[18], *c_re = kp->in[19], *c_im = kp->in[20], *d_skip = kp->in[21];
    const int gw = blockIdx.x * NWAVES + wid, NGW = gridDim.x * NWAVES;
    const int arow = 128 * ((l31 >> 2) & 1) + (l31 & 3) + 4 * (l31 >> 3);
    int gprev = -1;
    float lbr[2] = {0.f, 0.f}, lbi[2] = {0.f, 0.f}, p128r[2] = {0.f, 0.f}, p128i[2] = {0.f, 0.f}; bf16x8 bbf[4]; bf16x8 cf[8], df[2];
    for (int it = gw; it < 8192; it += NGW) {
        const int g = it & 63, b = (it >> 6) & 3, cp = it >> 8, ck = 2 * cp + hi;
        const size_t rowA = (size_t)b * SEQ + cp * 256;
        const float* shp = shiftl + (size_t)b * NMOD + 16 * g + 8 * hi; const f32x4 sh0 = *(const f32x4*)shp, sh1 = *(const f32x4*)(shp + 4);
        u32x4 uraw; f32x4 sp[4];
#define S5_ULOAD(blk_) do { const size_t row_ = rowA + arow + 16 * (blk_); uraw = *(const u32x4*)(hb + row_ * D + 16 * g + 8 * hi); \
            _Pragma("unroll") for (int pn_ = 0; pn_ < 4; ++pn_) sp[pn_] = *(const f32x4*)(ss + ((size_t)pn_ * M + row_) * 4); } while (0)
#define S5_UPACK(dst_) do { float t_ = 0.f; _Pragma("unroll") for (int pn_ = 0; pn_ < 4; ++pn_) t_ += (sp[pn_][0] + sp[pn_][1]) + (sp[pn_][2] + sp[pn_][3]); const float r_ = rs_of(t_); \
            dst_ = __builtin_bit_cast(bf16x8, pack8((f32x4){bf_lo(uraw.x), bf_hi(uraw.x), bf_lo(uraw.y), bf_hi(uraw.y)} * r_ + sh0, (f32x4){bf_lo(uraw.z), bf_hi(uraw.z), bf_lo(uraw.w), bf_hi(uraw.w)} * r_ + sh1)); } while (0)
        S5_ULOAD(0);
        if (g != gprev) {
        gprev = g;
        const float dt = __expf(log_dt[g]);
#pragma unroll
        for (int s2 = 0; s2 < 2; ++s2) {
            const int gn = g * 64 + l31 + 32 * s2;
            const float ar = lam_re[gn], ai = lam_im[gn];
            const float mag = __expf(ar * dt);
            float th = ai * dt; { const float kq = rintf(th * 0.15915494309189535f); th = fmaf(-kq, 6.28318548202514648f, th); th = fmaf(-kq, -1.7484555e-7f, th); }
            lbr[s2] = mag * cosf(th); lbi[s2] = mag * sinf(th);
            const float den = ar * ar + ai * ai, nr = lbr[s2] - 1.0f, ni = lbi[s2];
            const float kr = (nr * ar + ni * ai) / den, ki = (ni * ar - nr * ai) / den;
            const f32x4 br0 = *(const f32x4*)(b_re + (size_t)gn * 16 + 8 * hi), br1 = *(const f32x4*)(b_re + (size_t)gn * 16 + 8 * hi + 4);
            const f32x4 bi0 = *(const f32x4*)(b_im + (size_t)gn * 16 + 8 * hi), bi1 = *(const f32x4*)(b_im + (size_t)gn * 16 + 8 * hi + 4);
            bbf[s2] = __builtin_bit_cast(bf16x8, pack8(br0 * kr - bi0 * ki, br1 * kr - bi1 * ki));
            bbf[2 + s2] = __builtin_bit_cast(bf16x8, pack8(bi0 * kr + br0 * ki, bi1 * kr + br1 * ki));
        }
        if (PASS_B) {
#pragma unroll
            for (int s2 = 0; s2 < 2; ++s2) {
                float pr = lbr[s2], pi = lbi[s2];
#pragma unroll
                for (int q = 0; q < 7; ++q) { const float t = pr * pr - pi * pi; pi = 2.0f * pr * pi; pr = t; }
                p128r[s2] = pr; p128i[s2] = pi;
            }
            const int ci = l31 & 15; const bool cv = l31 < 16;
#pragma unroll
            for (int ks = 0; ks < 8; ++ks) {
                const float* cp2 = (ks < 4 ? c_re : c_im) + ((size_t)g * 16 + ci) * 64 + 16 * (ks & 3) + 8 * hi;
                f32x4 a = *(const f32x4*)cp2, bq = *(const f32x4*)(cp2 + 4);
                if (ks >= 4) { a = -a; bq = -bq; }
                if (!cv) { a = (f32x4){0.f, 0.f, 0.f, 0.f}; bq = a; }
                cf[ks] = __builtin_bit_cast(bf16x8, pack8(a, bq));
            }
            { const float dv = d_skip[16 * g + ci]; const unsigned dh = pk_bf16(dv, 0.f) & 0xffffu; const float dl = dv - bf_lo(dh); const unsigned dlo = pk_bf16(dl, 0.f) & 0xffffu;
              bf16x8 z = {0, 0, 0, 0, 0, 0, 0, 0}; df[0] = z; df[1] = z;
              const int j = ci - 8 * hi;
#pragma unroll
              for (int jj = 0; jj < 8; ++jj) if (cv && jj == j) { df[0][jj] = (short)dh; df[1][jj] = (short)dlo; } }
        }
        }
        float xr[2] = {0.f, 0.f}, xi[2] = {0.f, 0.f};
        if (PASS_B) {
            const f32x2* Ep0 = Ebuf + (((size_t)b * 64 + g) * 64) * 64 + l31;
            const int ckmax = 2 * cp + 1;
            for (int cb0 = 0; cb0 < ckmax; cb0 += 4) {
                f32x2 e0[4], e1[4];
#pragma unroll
                for (int k = 0; k < 4; ++k) { const int c2 = (cb0 + k < ckmax) ? cb0 + k : ckmax - 1; e0[k] = Ep0[(size_t)c2 * 64]; e1[k] = Ep0[(size_t)c2 * 64 + 32]; }
#pragma unroll
                for (int k = 0; k < 4; ++k) if (cb0 + k < ck) {
                    float t = p128r[0] * xr[0] - p128i[0] * xi[0] + e0[k].x; xi[0] = p128r[0] * xi[0] + p128i[0] * xr[0] + e0[k].y; xr[0] = t;
                    t = p128r[1] * xr[1] - p128i[1] * xi[1] + e1[k].x; xi[1] = p128r[1] * xi[1] + p128i[1] * xr[1] + e1[k].y; xr[1] = t; }
            }
        }
        bf16x8 uf; S5_UPACK(uf);
#pragma unroll 1
        for (int blk = 0; blk < 8; ++blk) {
            if (blk < 7) S5_ULOAD(blk + 1);
            f32x16 bu[4];
            { f32x16 z;
#pragma unroll
              for (int r = 0; r < 16; ++r) z[r] = 0.f;
#pragma unroll
              for (int cb = 0; cb < 4; ++cb) bu[cb] = __builtin_amdgcn_mfma_f32_32x32x16_bf16(uf, bbf[cb], z, 0, 0, 0); }
#pragma unroll
            for (int r = 0; r < 16; ++r) {
#pragma unroll
                for (int s2 = 0; s2 < 2; ++s2) { const float t2 = lbr[s2] * xr[s2] - lbi[s2] * xi[s2] + bu[s2][r]; xi[s2] = lbr[s2] * xi[s2] + lbi[s2] * xr[s2] + bu[2 + s2][r]; xr[s2] = t2;
                    bu[s2][r] = xr[s2]; bu[2 + s2][r] = xi[s2]; }
            }
            if (PASS_B) {
#pragma unroll
                for (int r = 0; r < 16; ++r) { LAS bf16_t* xp = (LAS bf16_t*)(xS + crow(r, hi) * XROW) + l31;
#pragma unroll
                    for (int cb = 0; cb < 4; ++cb) xp[32 * cb] = (bf16_t)(pk_bf16(bu[cb][r], 0.f) & 0xffffu); }
                f32x16 y;
#pragma unroll
                for (int r = 0; r < 16; ++r) y[r] = 0.f;
                y = __builtin_amdgcn_mfma_f32_32x32x16_bf16(uf, df[0], y, 0, 0, 0);
                y = __builtin_amdgcn_mfma_f32_32x32x16_bf16(uf, df[1], y, 0, 0, 0);
#pragma unroll
                for (int ks = 0; ks < 8; ++ks) { const bf16x8 af = *(const LAS bf16x8*)(xS + l31 * XROW + (16 * ks + 8 * hi) * 2); y = __builtin_amdgcn_mfma_f32_32x32x16_bf16(af, cf[ks], y, 0, 0, 0); }
                if (l31 < 16) {
#pragma unroll
                    for (int r = 0; r < 16; ++r) gout[(rowA + 128 * hi + 16 * blk + r) * D + 16 * g + l31] = (bf16_t)(pk_bf16(gelu_tanh(y[r]), 0.f) & 0xffffu);
                }
            }
            if (blk < 7) S5_UPACK(uf);
        }
#undef S5_ULOAD
#undef S5_UPACK
        if (!PASS_B) {
#pragma unroll
            for (int s2 = 0; s2 < 2; ++s2) Ebuf[((((size_t)b * 64 + g) * 64) + ck) * 64 + l31 + 32 * s2] = (f32x2){xr[s2], xi[s2]};
        }
    }
}

#define XB_TMO      128
#define XB_XCNT(j)  (256  + 64 * (j))
#define XB_XSUB(j)  (1280 + 64 * (j))
#define XB_XGEN(j)  (2304 + 64 * (j))
#define XB_TOP      3328
#define XB_TOPGEN   3392
#define XCD_BAR_WORDS 3456
#define XB_SPIN_CAP (1u << 18)

__device__ __forceinline__ unsigned xb_ld(unsigned* p)              { return __hip_atomic_load(p, __ATOMIC_RELAXED, __HIP_MEMORY_SCOPE_AGENT); }
__device__ __forceinline__ unsigned xb_add(unsigned* p, unsigned v) { return __hip_atomic_fetch_add(p, v, __ATOMIC_RELAXED, __HIP_MEMORY_SCOPE_AGENT); }
__device__ __forceinline__ unsigned xb_xcc_id() { return (unsigned)__builtin_amdgcn_s_getreg((3 << 11) | 20) & 0xFu; }
#define XB_SPIN(cond, bar) do { unsigned _sp = 0; while (cond) { __builtin_amdgcn_s_sleep(1); \
    if ((++_sp & 255u) == 0u) { if (xb_ld(&(bar)[XB_TMO])) break; if (_sp > XB_SPIN_CAP) { atomicAdd(&(bar)[XB_TMO], 1u); break; } } } } while (0)

struct XcdBarrier {
    unsigned* bar; unsigned x;
    volatile LAS unsigned* st;
};

__device__ __forceinline__ XcdBarrier xcd_barrier_post(unsigned* bar, volatile LAS unsigned* st) {
    XcdBarrier b; b.bar = bar; b.x = xb_xcc_id(); b.st = st;
    if (threadIdx.x == 0) (void)xb_add(&bar[XB_XCNT(b.x)], 1u);
    return b;
}
__device__ __forceinline__ void xcd_barrier_complete(unsigned* bar, unsigned x, unsigned& nloc, unsigned& nx) {
    const unsigned G = gridDim.x * gridDim.y * gridDim.z;
    unsigned sum, cnt, mine, sp = 0u;
    for (;;) {
        sum = 0u; cnt = 0u; mine = 0u;
#pragma unroll
        for (unsigned j = 0; j < 16; ++j) { const unsigned c = xb_ld(&bar[XB_XCNT(j)]); sum += c; cnt += (c > 0u) ? 1u : 0u; mine = (j == x) ? c : mine; }
        if (sum == G) break;
        __builtin_amdgcn_s_sleep(1);
        if ((++sp & 255u) == 0u) { if (xb_ld(&bar[XB_TMO])) break; if (sp > XB_SPIN_CAP) { atomicAdd(&bar[XB_TMO], 1u); break; } }
    }
    nloc = mine > 0u ? mine : 1u; nx = cnt > 0u ? cnt : 1u;
}

__device__ __forceinline__ void xcd_barrier(const XcdBarrier& b) {
    asm volatile("s_waitcnt vmcnt(0)" ::: "memory");
    __syncthreads();
    if (threadIdx.x == 0) {
        unsigned* bar = b.bar;
        __builtin_amdgcn_s_waitcnt(0);
        unsigned nloc = b.st[0], nx = b.st[1];
        if (nloc == 0u) { xcd_barrier_complete(bar, b.x, nloc, nx); b.st[0] = nloc; b.st[1] = nx; }
        const unsigned old = xb_add(&bar[XB_XSUB(b.x)], 1u);
        const unsigned gen = old / nloc;
        if (old + 1u == (gen + 1u) * nloc) {
            __builtin_amdgcn_fence(__ATOMIC_RELEASE, "agent");
            asm volatile("s_waitcnt vmcnt(0)" ::: "memory");
            const unsigned og = xb_add(&bar[XB_TOP], 1u);
            const unsigned tg = og / nx;
            if (og + 1u == (tg + 1u) * nx) xb_add(&bar[XB_TOPGEN], 1u);
            else XB_SPIN(xb_ld(&bar[XB_TOPGEN]) == tg, bar);
            __builtin_amdgcn_fence(__ATOMIC_ACQUIRE, "agent");
            xb_add(&bar[XB_XGEN(b.x)], 1u);
            asm volatile("s_waitcnt vmcnt(0)" ::: "memory");
        } else {
            XB_SPIN(xb_ld(&bar[XB_XGEN(b.x)]) == gen, bar);
            __builtin_amdgcn_fence(__ATOMIC_ACQUIRE, "agent");
            asm volatile("s_waitcnt vmcnt(0)" ::: "memory");
        }
    }
    __syncthreads();
}


enum Kind { K_PROLOGUE, K_NORM, K_FFNIN, K_FFNOUT, K_POOL_EW, K_POOL_GEMM, K_QKV, K_CUMSUM, K_ATTN, K_WO, K_S5A, K_S5B, K_GLU, K_CONVIN, K_CONV_EW, K_CONVOUT };
constexpr int NPHASES = 2 + 6 + 7 + 7 + 7;
__host__ __device__ inline void decode_phase(int ph, int& layer, int& kind, int& sub) {
    layer = 0; sub = 0; kind = K_PROLOGUE; if (ph == 0) return;
    if (ph == 1) { kind = K_NORM; return; }
    int r = ph - 2;
    for (int l = 0; l < 4; ++l) {
        const int nm = (l == 0) ? 2 : 3, n = 4 + nm;
        if (r < n) { layer = l;
            if (r < 2) { sub = 0; kind = r == 0 ? K_FFNIN : K_FFNOUT; }
            else if (r < 2 + nm) { sub = 1; const int q = r - 2;
                kind = l == 0 ? (q == 0 ? K_POOL_EW : K_POOL_GEMM) : l == 1 ? (q == 0 ? K_QKV : q == 1 ? K_ATTN : K_WO)
                     : l == 2 ? (q == 0 ? K_S5A : q == 1 ? K_S5B : K_GLU) : (q == 0 ? K_CONVIN : q == 1 ? K_CONV_EW : K_CONVOUT); }
            else { sub = 2; const int q = r - 2 - nm; kind = q == 0 ? K_FFNIN : K_FFNOUT; }
            return; }
        r -= n;
    }
}

__global__ void __launch_bounds__(NTHREADS, 2) mega_fwd(Params p_arg) {
    extern __shared__ __attribute__((aligned(16))) unsigned char lds_raw[];
    LAS unsigned char* lds = (LAS unsigned char*)lds_raw;
    cg::grid_group grid = cg::this_grid();
    const KP kp0 = (KP)__builtin_amdgcn_kernarg_segment_ptr();
    const int lo = kp0->lo, hi = kp0->hi;
    volatile LAS unsigned* bst = (volatile LAS unsigned*)(lds + LDS_MAIN + LDS_SSL);
    if (threadIdx.x < 4) bst[threadIdx.x] = 0u;
    __syncthreads();
    const XcdBarrier xbar = xcd_barrier_post((unsigned*)(kp0->ws + WS_BAR), bst);
#define WSP(T, off) ((T*)(ws + (off)))
    for (int ph = lo; ph < hi; ++ph) {
        KP kp = kp0; asm volatile("" : "+s"(kp));
        int layer, kind, sub; decode_phase(ph, layer, kind, sub);
        const int reps = 1 + ((REPMASK >> kind) & 1);
        for (int rep = 0; rep < reps; ++rep) {
        if (rep) xcd_barrier(xbar);
        unsigned char* ws = kp->ws;
        const int sidx = layer * 3 + sub;
        switch (kind) {
        case K_PROLOGUE: prologue_phase(kp, lds, rep); break;
        case K_NORM: norm0_phase(kp); break;
        case K_FFNIN: {
            const int ffi = layer * 2 + (sub == 2 ? 1 : 0);
            const pg8::Gemm g{WSP(const bf16_t, WS_HB), WSP(const bf16_t, WS_WFFIN) + (size_t)ffi * 2 * DFF * D, M, 2 * DFF, D, D, 0};
            pg8::StaticOrder S; S.init(M, 2 * DFF, gridDim.x, blockIdx.x);
            const EpiSwiglu E{WSP(bf16_t, WS_HH), WSP(const float, WS_SS) + (size_t)(sidx & 1) * 16 * M, WSP(const float, WS_BIASV) + (size_t)ffi * BV_FFN, (const LAS float*)(lds + LDS_MAIN)};
            pg8::gemm_phase<EpiSwiglu, true>(lds, g, S, E);
        } break;
        case K_QKV: {
            const pg8::Gemm g{WSP(const bf16_t, WS_HB), WSP(const bf16_t, WS_WFOXIN), M, NFOX, D, D, 0};
            pg8::StaticOrder S; S.init(M, NFOX, gridDim.x, blockIdx.x);
            const EpiQKV E{WSP(bf16_t, WS_R2), WSP(float, WS_LOGF), kp->in[11], kp->in[12], kp->in[10], WSP(const float, WS_SS) + (size_t)(sidx & 1) * 16 * M, WSP(const float, WS_BIASV) + BV_QKV_OFF, (const LAS float*)(lds + LDS_MAIN)};
            pg8::gemm_phase<EpiQKV, true>(lds, g, S, E);
        } break;
        case K_CONVIN: {
            const pg8::Gemm g{WSP(const bf16_t, WS_HB), WSP(const bf16_t, WS_WCONVIN), M, 3 * D, D, D, 0};
            pg8::StaticOrder S; S.init(M, 3 * D, gridDim.x, blockIdx.x);
            const EpiConvIn E{WSP(bf16_t, WS_R2), WSP(bf16_t, WS_R3), WSP(const float, WS_SS) + (size_t)(sidx & 1) * 16 * M, WSP(const float, WS_BIASV) + BV_CONV_OFF, (const LAS float*)(lds + LDS_MAIN)};
            pg8::gemm_phase<EpiConvIn, true>(lds, g, S, E);
        } break;
        case K_FFNOUT: case K_POOL_GEMM: case K_WO: case K_GLU: case K_CONVOUT: {
            const int ffi = layer * 2 + (sub == 2 ? 1 : 0);
            size_t aoff = WS_R2, boff; int K = D, lda = D, apn = 0; float coef = 1.0f; const float* colscale = nullptr; const bf16_t* glu = nullptr;
            if (kind == K_FFNOUT) { aoff = WS_HH; boff = WS_WFFOUT + (size_t)ffi * D * DFF * 2; K = DFF; lda = DFF; coef = 0.5f; }
            else if (kind == K_POOL_GEMM) { boff = WS_WPOOL; K = 256; apn = 256; colscale = kp->in[8]; }
            else if (kind == K_WO) { aoff = WS_HH; boff = WS_WFOXO; }
            else if (kind == K_GLU) { boff = WS_WGLU; glu = WSP(const bf16_t, WS_R2); }
            else { aoff = WS_R4; boff = WS_WCONVOUT; }
            const pg8::Gemm g{WSP(const bf16_t, aoff), WSP(const bf16_t, boff), M, D, K, lda, apn};
            pg8::StaticOrder S; S.init(M, D, gridDim.x, blockIdx.x);
            if (kind == K_GLU) {
                const EpiRes<true> E{WSP(const _Float16, WS_XH), nullptr, WSP(_Float16, WS_XH), WSP(const float, WS_MOD) + (size_t)layer * 4 * NMOD + (sub * 3 + 2) * D, colscale, glu,
                                     WSP(const float, WS_GS) + (size_t)(sidx + 1) * 4 * D, WSP(float, WS_SS) + (size_t)((sidx + 1) & 1) * 16 * M, WSP(bf16_t, WS_HB), (rep + 1 < reps) ? 0.0f : coef, 0};
                pg8::gemm_phase<EpiRes<true>, true>(lds, g, S, E);
            } else {
                const EpiRes<false> E{WSP(const _Float16, WS_XH), sidx == 11 ? kp->out : nullptr, WSP(_Float16, WS_XH), WSP(const float, WS_MOD) + (size_t)layer * 4 * NMOD + (sub * 3 + 2) * D, colscale, glu,
                                      sidx < 11 ? WSP(const float, WS_GS) + (size_t)(sidx + 1) * 4 * D : nullptr, WSP(float, WS_SS) + (size_t)((sidx + 1) & 1) * 16 * M, WSP(bf16_t, WS_HB), (rep + 1 < reps) ? 0.0f : coef, 0};
                pg8::gemm_phase<EpiRes<false>, true>(lds, g, S, E);
            }
        } break;
        case K_POOL_EW: pool_phase(WSP(const bf16_t, WS_HB), WSP(const float, WS_SS) + (size_t)(sidx & 1) * 16 * M, WSP(const float, WS_MOD) + (size_t)layer * 4 * NMOD + 3 * D, WSP(bf16_t, WS_R2)); break;
        case K_CUMSUM: cumsum_phase(WSP(const float, WS_LOGF), WSP(float, WS_BIASK), lds); break;
        case K_ATTN: attn_phase(lds, WSP(const bf16_t, WS_R2), WSP(const bf16_t, WS_R3), WSP(const bf16_t, WS_R4), WSP(bf16_t, WS_HH), WSP(const float, WS_LOGF), kp->in[11], kp->in[12]); break;
        case K_S5A: s5_phase<false>(kp, lds, WSP(const bf16_t, WS_HB), WSP(const float, WS_SS) + (size_t)(sidx & 1) * 16 * M, WSP(const float, WS_MOD) + (size_t)layer * 4 * NMOD + 3 * D, WSP(f32x2, WS_E), WSP(bf16_t, WS_R2)); break;
        case K_S5B: s5_phase<true>(kp, lds, WSP(const bf16_t, WS_HB), WSP(const float, WS_SS) + (size_t)(sidx & 1) * 16 * M, WSP(const float, WS_MOD) + (size_t)layer * 4 * NMOD + 3 * D, WSP(f32x2, WS_E), WSP(bf16_t, WS_R2)); break;
        case K_CONV_EW: conv_phase(WSP(const bf16_t, WS_R2), WSP(const bf16_t, WS_R3), kp->in[24], WSP(bf16_t, WS_R4)); break;
        default: break;
        }
        }
        if (ph + 1 < hi) { if (ph == lo) grid.sync(); else xcd_barrier(xbar); }
    }
#undef WSP
}

extern "C" void kernel_launch(void* const* d_in, const int* in_sizes, int n_in, void* d_out, int out_size, void* d_ws, size_t ws_size, hipStream_t stream) {
    static int grid = 0;
    if (grid == 0) {
        if (n_in != 26 || out_size != M * D || ws_size < WS_END) { fprintf(stderr, "kernel_launch: unexpected shapes (n_in %d out %d ws %zu)\n", n_in, out_size, ws_size); grid = -1; return; }
        int dev = 0, cus = 0, per_cu = 0;
        (void)hipGetDevice(&dev); (void)hipDeviceGetAttribute(&cus, hipDeviceAttributeMultiprocessorCount, dev);
        if (hipFuncSetAttribute((const void*)mega_fwd, hipFuncAttributeMaxDynamicSharedMemorySize, LDS_BYTES) != hipSuccess) { fprintf(stderr, "kernel_launch: hipFuncSetAttribute failed\n"); grid = -1; return; }
        if (hipOccupancyMaxActiveBlocksPerMultiprocessor(&per_cu, (const void*)mega_fwd, NTHREADS, LDS_BYTES) != hipSuccess || per_cu < 1) { fprintf(stderr, "kernel_launch: occupancy query gave %d\n", per_cu); per_cu = 1; }
        (void)hipGetLastError();
        grid = cus * per_cu;
        fprintf(stderr, "kernel_launch: grid %d (cus %d x %d)\n", grid, cus, per_cu);
    }
    if (grid < 0) return;
    (void)hipMemsetAsync((unsigned char*)d_ws + WS_BAR, 0, BAR_BYTES, stream);
    Params p{};
    for (int i = 0; i < 26; ++i) p.in[i] = (const float*)d_in[i];
    p.out = (float*)d_out; p.ws = (unsigned char*)d_ws;
#if MK_ONE_LAUNCH
    p.lo = 0; p.hi = NPHASES;
    void* args[] = {&p};
    hipError_t e = hipLaunchCooperativeKernel((const void*)mega_fwd, dim3(grid), dim3(NTHREADS), args, LDS_BYTES, stream);
    if (e != hipSuccess) fprintf(stderr, "cooperative launch failed: %s (grid %d)\n", hipGetErrorString(e), grid);
#else
    for (int ph = 0; ph < NPHASES; ++ph) {
        p.lo = ph; p.hi = ph + 1;
        hipLaunchKernelGGL(mega_fwd, dim3(grid), dim3(NTHREADS), LDS_BYTES, stream, p);
    }
#endif
}
```

```cpp
#include <hip/hip_runtime.h>
#include <hip/hip_cooperative_groups.h>
#include <cstdio>
#include <cstdint>
namespace cg = cooperative_groups;

#ifndef REPMASK
#define REPMASK 0
#endif
#ifndef MK_ONE_LAUNCH
#define MK_ONE_LAUNCH 1
#endif

#define LAS __attribute__((address_space(3)))
typedef unsigned short bf16_t;
typedef short bf16x8 __attribute__((ext_vector_type(8)));
typedef float f32x4 __attribute__((ext_vector_type(4)));
typedef float f32x2 __attribute__((ext_vector_type(2)));
typedef float f32x16 __attribute__((ext_vector_type(16)));
typedef unsigned u32x4 __attribute__((ext_vector_type(4)));
typedef unsigned u32x2 __attribute__((ext_vector_type(2)));
typedef __bf16 bf16x2_t __attribute__((ext_vector_type(2)));
typedef _Float16 h16x4 __attribute__((ext_vector_type(4)));

constexpr int D = 1024, BATCH = 4, SEQ = 8192, M = BATCH * SEQ, DFF = 2816, NMOD = 9 * D;
constexpr int NFOX = 3328;
constexpr float EPS = 1e-6f;
constexpr float LOG2E = 1.4426950408889634f;
constexpr float QSCALE = 0.125f * LOG2E;
constexpr int NTHREADS = 512, NWAVES = 8;
constexpr int LDS_MAIN = 131072, LDS_SSL = 16384 + 2048, LDS_BYTES = LDS_MAIN + LDS_SSL + 64;

constexpr size_t MiB = 1u << 20;
constexpr size_t WS_MOD = 0, WS_LOGF = 1 * MiB, WS_BIASK = 3 * MiB, WS_E = 5 * MiB, WS_BAR = 13 * MiB, BAR_BYTES = 16384;
constexpr size_t WS_WFFIN = 16 * MiB, WS_WFFOUT = 104 * MiB, WS_WFOXIN = 148 * MiB, WS_WFOXO = 155 * MiB, WS_WGLU = 157 * MiB,
                 WS_WCONVIN = 159 * MiB, WS_WCONVOUT = 165 * MiB, WS_WPOOL = 167 * MiB;
constexpr size_t WS_SS = 172 * MiB, WS_BIASV = 170 * MiB, WS_GS = 171 * MiB;
constexpr int BV_FFN = 4 * 2 * DFF, BV_QKV_OFF = 8 * BV_FFN, BV_CONV_OFF = BV_QKV_OFF + 4 * NFOX, BV_TOTAL = BV_CONV_OFF + 4 * 3 * D;
constexpr size_t WS_HB = 176 * MiB, WS_HH = 240 * MiB, WS_R2 = 416 * MiB, WS_R3 = 480 * MiB, WS_R4 = 544 * MiB, WS_XH = 608 * MiB, WS_END = 672 * MiB;

struct Params { const float* in[26]; float* out; unsigned char* ws; int lo, hi; };
typedef const __attribute__((address_space(4))) Params* KP;

__device__ __forceinline__ unsigned pk_bf16(float lo, float hi) { f32x2 v = {lo, hi}; bf16x2_t b = __builtin_convertvector(v, bf16x2_t); return __builtin_bit_cast(unsigned, b); }
__device__ __forceinline__ float bf_lo(unsigned w) { return __uint_as_float(w << 16); }
__device__ __forceinline__ float bf_hi(unsigned w) { return __uint_as_float(w & 0xffff0000u); }
__device__ __forceinline__ float wave_sum(float v) {
#pragma unroll
    for (int o = 1; o < 64; o <<= 1) v += __shfl_xor(v, o);
    return v;
}
__device__ __forceinline__ float fast_sigmoid(float x) { return __builtin_amdgcn_rcpf(1.0f + __builtin_amdgcn_exp2f(-x * LOG2E)); }
__device__ __forceinline__ float silu_f(float x) { return x * fast_sigmoid(x); }
__device__ __forceinline__ float gelu_tanh(float y) {
    const float z = 0.7978845608028654f * (y + 0.044715f * y * y * y);
    const float t = 1.0f - 2.0f * __builtin_amdgcn_rcpf(1.0f + __builtin_amdgcn_exp2f(2.0f * LOG2E * z));
    return 0.5f * y * (1.0f + t);
}
__device__ __forceinline__ float rs_of(float ss) { return rsqrtf(ss * (1.0f / D) + EPS); }
__device__ __forceinline__ float rs_row(const float* ssp, size_t row) { float t = 0.f;
#pragma unroll
    for (int pn = 0; pn < 4; ++pn) { const f32x4 v = *(const f32x4*)(ssp + ((size_t)pn * M + row) * 4); t += (v[0] + v[1]) + (v[2] + v[3]); }
    return rs_of(t); }
__device__ __forceinline__ float log_sigmoid(float z) { return fminf(z, 0.f) - 0.6931471805599453f * __builtin_amdgcn_logf(1.0f + __builtin_amdgcn_exp2f(-fabsf(z) * LOG2E)); }

__device__ __forceinline__ int opaque_tid() { int t = threadIdx.x; asm volatile("" : "+v"(t)); return t; }
template <int OFF> __device__ __forceinline__ void gld16(f32x4& v, const void* p) { asm volatile("global_load_dwordx4 %0, %1, off offset:%2" : "=&v"(v) : "v"(p), "i"(OFF) : "memory"); }
template <int OFF> __device__ __forceinline__ void gld8(u32x2& v, const void* p) { asm volatile("global_load_dwordx2 %0, %1, off offset:%2" : "=&v"(v) : "v"(p), "i"(OFF) : "memory"); }
__device__ __forceinline__ void gwait8(f32x4 (&v)[8]) { asm volatile("s_waitcnt vmcnt(0)" : "+v"(v[0]), "+v"(v[1]), "+v"(v[2]), "+v"(v[3]), "+v"(v[4]), "+v"(v[5]), "+v"(v[6]), "+v"(v[7]) :: "memory"); }
__device__ __forceinline__ void gwait4(f32x4 (&v)[4]) { asm volatile("s_waitcnt vmcnt(0)" : "+v"(v[0]), "+v"(v[1]), "+v"(v[2]), "+v"(v[3]) :: "memory"); }
__device__ __forceinline__ void gwait8u(u32x2 (&v)[8]) { asm volatile("s_waitcnt vmcnt(0)" : "+v"(v[0]), "+v"(v[1]), "+v"(v[2]), "+v"(v[3]), "+v"(v[4]), "+v"(v[5]), "+v"(v[6]), "+v"(v[7]) :: "memory"); }
__device__ __forceinline__ void load_r8(const float* ssp, int row0, int fq, float (&r8)[2][4]) {
    f32x4 pv[8]; const float* p0 = ssp + ((size_t)fq * M + row0) * 4;
    gld16<0>(pv[0], p0); gld16<256>(pv[1], p0); gld16<512>(pv[2], p0); gld16<768>(pv[3], p0);
    gld16<2048>(pv[4], p0); gld16<2304>(pv[5], p0); gld16<2560>(pv[6], p0); gld16<2816>(pv[7], p0);
    gwait8(pv);
#pragma unroll
    for (int i = 0; i < 8; ++i) { float t = (pv[i][0] + pv[i][1]) + (pv[i][2] + pv[i][3]); t += __shfl_xor(t, 16); t += __shfl_xor(t, 32); r8[i >> 2][i & 3] = rs_of(t); }
}
__device__ __forceinline__ void load_r8_lds(const LAS float* ssl, int wr, int fr, int fq, float (&r8)[2][4]) {
#pragma unroll
    for (int i = 0; i < 8; ++i) { const f32x4 v = *(const LAS f32x4*)(ssl + (fq * 256 + (i >> 2) * 128 + wr * 64 + (i & 3) * 16 + fr) * 4);
        float t = (v[0] + v[1]) + (v[2] + v[3]); t += __shfl_xor(t, 16); t += __shfl_xor(t, 32); r8[i >> 2][i & 3] = rs_of(t); }
}
namespace pg8 {
constexpr int BM = 256, BK = 64, HALF = 128, HTB = HALF * BK * 2, STAGE_BYTES = 8 * HTB, NXCD = 8, WGM = 8;
__host__ __device__ __forceinline__ int lds_byte(int r, int c) { const int st = (r >> 4) * 2 + (c >> 5), rr = r & 15, cc = c & 31, ob = rr * 64 + cc * 2; return st * 1024 + (ob ^ (((ob >> 9) & 1) << 5)); }
__host__ __device__ __forceinline__ void stage_rc(int b, int& R, int& C) { const int st = b / 1024, sb = b % 1024, swz = sb ^ (((sb >> 9) & 1) << 5); R = (st >> 1) * 16 + swz / 64; C = (st & 1) * 32 + (swz % 64) / 2; }
__host__ __device__ __forceinline__ int perm32(int rho) { const int n = rho >> 4, i = rho & 15; return 8 * (i >> 2) + 4 * n + (i & 3); }
struct Unit { int pm, pn; };
struct Gemm { const bf16_t* A; const bf16_t* Bt; int M, N, K, lda, apn; };
struct StaticOrder {
    int nM, nN, nwg, G, c;
    __device__ void init(int M_, int N_, int G_, int c_) { nM = M_ / BM; nN = N_ / BM; nwg = nM * nN; G = G_; c = c_; }
    __device__ bool next(int i, Unit& u) const {
        const long L = (long)i * G + c; if (L >= nwg) return false;
        int wgid = (int)L; { const int q = nwg / NXCD, r = nwg % NXCD, xcd = wgid % NXCD, off = wgid / NXCD; wgid = (xcd < r ? xcd * (q + 1) : r * (q + 1) + (xcd - r) * q) + off; }
        const int nig = WGM * nN, gid = wgid / nig, fm = gid * WGM, gsz = (nM - fm) < WGM ? (nM - fm) : WGM;
        u.pm = fm + ((wgid % nig) % gsz); u.pn = (wgid % nig) / gsz; return true;
    }
};
template <class Epi, bool PG8_ALIGN_EPI>
__device__ __forceinline__ void gemm_phase(LAS unsigned char* lds, const Gemm g, const StaticOrder& S, const Epi& E) {
    const int tid = opaque_tid(), wid = __builtin_amdgcn_readfirstlane(tid >> 6), lane = tid & 63, wr = wid >> 2, wc = wid & 3, fr = lane & 15, fq = lane >> 4;
    const int K = g.K, nt = K / BK;
    unsigned voffA[2], voffB[2];
#pragma unroll
    for (int i = 0; i < 2; ++i) { int R, C; stage_rc(tid * 16 + i * 8192, R, C); const int Rb = (R & ~31) + perm32(R & 31);
        voffA[i] = (unsigned)(R * g.lda + C) * 2u; voffB[i] = (unsigned)(Rb * K + C) * 2u; }
    const size_t kstep = (size_t)(BK * 2);
    const size_t hstepA = (size_t)HALF * g.lda * 2, hstepB = (size_t)HALF * K * 2;
    const size_t tstepA = 2 * hstepA, tstepB = 2 * hstepB;
    const size_t apnb = (size_t)g.apn * 2;
    const unsigned ldsw = (unsigned)wid * 1024u;
    const int aoff = lds_byte(wr * 64 + fr, fq * 8), boff = lds_byte(wc * 32 + fr, fq * 8);
#define PG8_SA(b, h) (((b) * 2 + (h)) * HTB)
#define PG8_SB(b, h) ((4 + (b) * 2 + (h)) * HTB)
#define PG8_STAGE(bufoff, gbase, voff) do { _Pragma("unroll") for (int _i = 0; _i < 2; ++_i) \
        __builtin_amdgcn_global_load_lds((const unsigned*)((const char*)(gbase) + (voff)[_i]), (LAS unsigned*)(lds + (bufoff) + ldsw + _i * 8192), 16, 0, 0); } while (0)
#define PG8_LDA(dst, b, h) do { _Pragma("unroll") for (int m = 0; m < 4; ++m) _Pragma("unroll") for (int k = 0; k < 2; ++k) dst[m][k] = *(const LAS bf16x8*)(lds + PG8_SA(b, h) + aoff + m * 2048 + k * 1024); } while (0)
#define PG8_LDB(dst, b, h) do { _Pragma("unroll") for (int n = 0; n < 2; ++n) _Pragma("unroll") for (int k = 0; k < 2; ++k) dst[n][k] = *(const LAS bf16x8*)(lds + PG8_SB(b, h) + boff + n * 2048 + k * 1024); } while (0)
#define PG8_MMA(ai, bj, At, Bt) do { __builtin_amdgcn_s_setprio(1); _Pragma("unroll") for (int m = 0; m < 4; ++m) _Pragma("unroll") for (int n = 0; n < 2; ++n) _Pragma("unroll") for (int k = 0; k < 2; ++k) \
        acc[ai][bj][m][n] = __builtin_amdgcn_mfma_f32_16x16x32_bf16(Bt[n][k], At[m][k], acc[ai][bj][m][n], 0, 0, 0); __builtin_amdgcn_s_setprio(0); } while (0)
#define PG8_WAIT_V(n) asm volatile("s_waitcnt vmcnt(" #n ")" ::: "memory")
#define PG8_WAIT_L(n) asm volatile("s_waitcnt lgkmcnt(" #n ")" ::: "memory")
#define PG8_BAR __builtin_amdgcn_s_barrier()
#define PG8_SCHED __builtin_amdgcn_sched_barrier(0)
    Unit cur, nxt; int ui = 0;
    if (!S.next(0, cur)) return;
    f32x4 acc[2][2][4][2];
#pragma unroll
    for (int a = 0; a < 2; ++a)
#pragma unroll
        for (int b = 0; b < 2; ++b)
#pragma unroll
            for (int m = 0; m < 4; ++m)
#pragma unroll
                for (int n = 0; n < 2; ++n) acc[a][b][m][n] = (f32x4){0.f, 0.f, 0.f, 0.f};
    bf16x8 At[4][2], B0[2][2], B1[2][2];
    const char* cA = (const char*)g.A + (size_t)cur.pm * tstepA + (size_t)cur.pn * apnb; const char* cB = (const char*)g.Bt + (size_t)cur.pn * tstepB;
    PG8_STAGE(PG8_SB(0, 0), cB, voffB); PG8_STAGE(PG8_SB(0, 1), cB + hstepB, voffB); PG8_STAGE(PG8_SA(0, 0), cA, voffA); PG8_STAGE(PG8_SA(0, 1), cA + hstepA, voffA);
    if (wr == 1) PG8_BAR;
    PG8_WAIT_V(2); PG8_BAR;
    PG8_STAGE(PG8_SB(1, 0), cB + kstep, voffB); PG8_STAGE(PG8_SA(1, 0), cA + kstep, voffA); PG8_STAGE(PG8_SB(1, 1), cB + hstepB + kstep, voffB);
    PG8_WAIT_V(6); PG8_BAR;
#define PG8_SSDMA(u_) do { if constexpr (Epi::HAS_SS) { int ln_ = lane; asm volatile("" : "+v"(ln_)); const int pn_ = wid >> 1; \
        _Pragma("unroll") for (int jj_ = 0; jj_ < 2; ++jj_) { const int j_ = 2 * (wid & 1) + jj_; \
            __builtin_amdgcn_global_load_lds((const unsigned*)(E.ss + ((size_t)pn_ * M + 256 * (u_).pm + 64 * j_ + ln_) * 4), (LAS unsigned*)(lds + LDS_MAIN + (pn_ * 256 + 64 * j_) * 16), 16, 0, 0); } \
        if (wid < Epi::NAUX) __builtin_amdgcn_global_load_lds((const unsigned*)E.aux(wid, (u_), ln_), (LAS unsigned*)(lds + LDS_MAIN + 16384 + wid * 1024), 16, 0, 0); } } while (0)
    PG8_SSDMA(cur);
    for (;;) {
        const bool has_next = S.next(ui + 1, nxt);
        const char* nA = has_next ? (const char*)g.A + (size_t)nxt.pm * tstepA + (size_t)nxt.pn * apnb : cA; const char* nB = has_next ? (const char*)g.Bt + (size_t)nxt.pn * tstepB : cB;
        for (int t = 0; t < nt; t += 2) {
            const bool last = (t == nt - 2);
            const char* a1 = cA + (size_t)(t + 1) * kstep;
            const char* a2 = last ? nA : cA + (size_t)(t + 2) * kstep; const char* b2 = last ? nB : cB + (size_t)(t + 2) * kstep;
            const char* a3 = a2 + kstep; const char* b3 = b2 + kstep;
            PG8_LDB(B0, 0, 0); PG8_LDB(B1, 0, 1); PG8_SCHED; PG8_LDA(At, 0, 0); PG8_STAGE(PG8_SA(1, 1), a1 + hstepA, voffA);
            PG8_WAIT_V(8); PG8_WAIT_L(0); PG8_BAR;
            PG8_MMA(0, 0, At, B0); PG8_MMA(0, 1, At, B1); PG8_BAR; PG8_SCHED;
            PG8_LDA(At, 0, 1); PG8_STAGE(PG8_SB(0, 0), b2, voffB); PG8_STAGE(PG8_SB(0, 1), b2 + hstepB, voffB); PG8_STAGE(PG8_SA(0, 0), a2, voffA);
            PG8_WAIT_V(8); PG8_WAIT_L(0); PG8_BAR; PG8_MMA(1, 0, At, B0); PG8_MMA(1, 1, At, B1); PG8_BAR; PG8_SCHED;
            PG8_LDB(B0, 1, 0); PG8_LDB(B1, 1, 1); PG8_SCHED; PG8_LDA(At, 1, 0); PG8_STAGE(PG8_SA(0, 1), a2 + hstepA, voffA);
            PG8_WAIT_V(8); PG8_WAIT_L(0); PG8_BAR; PG8_MMA(0, 0, At, B0); PG8_MMA(0, 1, At, B1); PG8_BAR; PG8_SCHED;
            PG8_LDA(At, 1, 1); PG8_STAGE(PG8_SB(1, 0), b3, voffB); PG8_STAGE(PG8_SB(1, 1), b3 + hstepB, voffB); PG8_STAGE(PG8_SA(1, 0), a3, voffA);
            PG8_WAIT_V(8); PG8_WAIT_L(0); PG8_BAR; PG8_MMA(1, 0, At, B0); PG8_MMA(1, 1, At, B1); PG8_BAR; PG8_SCHED;
        }
        if (PG8_ALIGN_EPI) { if (wr == 0) PG8_BAR; }
        { int fr_e = fr, fq_e = fq; asm volatile("" : "+v"(fr_e), "+v"(fq_e));
          E(acc, cur, wr, wc, fr_e, fq_e); }
        if (!has_next) break;
#pragma unroll
        for (int a = 0; a < 2; ++a)
#pragma unroll
            for (int b = 0; b < 2; ++b)
#pragma unroll
                for (int m = 0; m < 4; ++m)
#pragma unroll
                    for (int n = 0; n < 2; ++n) acc[a][b][m][n] = (f32x4){0.f, 0.f, 0.f, 0.f};
        cur = nxt; cA = nA; cB = nB; ++ui;
        if constexpr (Epi::HAS_SS) { PG8_BAR; PG8_SSDMA(cur); }
        if (PG8_ALIGN_EPI) { if (wr == 1) PG8_BAR; }
    }
    PG8_WAIT_V(0);
    if (!PG8_ALIGN_EPI) { if (wr == 0) PG8_BAR; }
    PG8_BAR;
#undef PG8_SA
#undef PG8_SB
#undef PG8_STAGE
#undef PG8_LDA
#undef PG8_LDB
#undef PG8_MMA
#undef PG8_WAIT_V
#undef PG8_WAIT_L
#undef PG8_BAR
#undef PG8_SCHED
#undef PG8_SSDMA
}
}
using pg8::Unit;

typedef const f32x4 (&AccRef)[2][2][4][2];
__device__ __forceinline__ u32x4 pack8(f32x4 a, f32x4 b) { u32x4 w; w.x = pk_bf16(a[0], a[1]); w.y = pk_bf16(a[2], a[3]); w.z = pk_bf16(b[0], b[1]); w.w = pk_bf16(b[2], b[3]); return w; }

struct EpiSwiglu {      static constexpr bool HAS_SS = true; static constexpr int NAUX = 1;
    bf16_t* O; const float* ss; const float* bias; const LAS float* ssl;
    __device__ __forceinline__ const float* aux(int, const Unit& u, int lane) const { return bias + (size_t)(u.pm >> 5) * (2 * DFF) + u.pn * 256 + 4 * lane; }
    __device__ __forceinline__ void operator()(AccRef acc, const Unit& u, int wr, int wc, int fr, int fq) const {
        const int row0 = u.pm * 256 + wr * 64 + fr, col0 = u.pn * 128 + wc * 32 + 8 * fq;
        const LAS float* bl = ssl + 4096 + wc * 32 + 8 * fq;
        const f32x4 bg[2] = {*(const LAS f32x4*)bl, *(const LAS f32x4*)(bl + 4)}, bu[2] = {*(const LAS f32x4*)(bl + 128), *(const LAS f32x4*)(bl + 132)};
        float r8[2][4]; load_r8_lds(ssl, wr, fr, fq, r8);
#pragma unroll
        for (int ai = 0; ai < 2; ++ai)
#pragma unroll
            for (int m = 0; m < 4; ++m) {
                const int row = row0 + ai * 128 + m * 16; const float r = r8[ai][m];
                f32x4 h[2];
#pragma unroll
                for (int n = 0; n < 2; ++n) { const f32x4 gg = acc[ai][0][m][n] * r + bg[n], uu = acc[ai][1][m][n] * r + bu[n];
#pragma unroll
                    for (int j = 0; j < 4; ++j) h[n][j] = silu_f(gg[j]) * uu[j]; }
                *(u32x4*)(O + (size_t)row * DFF + col0) = pack8(h[0], h[1]);
            }
    }
};

template <bool GLU> struct EpiRes {         static constexpr bool HAS_SS = false; static constexpr int NAUX = 0; static constexpr int RB = GLU ? 2 : 4;
    const _Float16* baseh; float* out32; _Float16* outh;
    const float* gate; const float* colscale; const bf16_t* glu; const float* gsn; float* ssn; bf16_t* xs; float coef; int pad;
    __device__ __forceinline__ void operator()(f32x4 (&acc)[2][2][4][2], const Unit& u, int wr, int wc, int fr, int fq) const {
        typedef _Float16 h16x8 __attribute__((ext_vector_type(8)));
        const int row0 = u.pm * 256 + wr * 64 + fr, col0 = u.pn * 256 + wc * 32 + 8 * fq;
        const float* gv = gate + (size_t)(u.pm >> 5) * NMOD;
        const float* gsb = gsn ? gsn + (size_t)(u.pm >> 5) * D : nullptr;
        f32x4 gm[2][2], gsv[2][2];
        { f32x4 gq[8];
          const float* gp0 = gv + col0; const float* gp1 = (gsb ? gsb : gv) + col0;
          gld16<0>(gq[0], gp0); gld16<16>(gq[1], gp0); gld16<512>(gq[2], gp0); gld16<528>(gq[3], gp0);
          gld16<0>(gq[4], gp1); gld16<16>(gq[5], gp1); gld16<512>(gq[6], gp1); gld16<528>(gq[7], gp1); gwait8(gq);
#pragma unroll
          for (int bj = 0; bj < 2; ++bj)
#pragma unroll
            for (int n = 0; n < 2; ++n) { const int c = col0 + bj * 128 + 4 * n; f32x4 t = (gq[bj * 2 + n] + 1.0f) * coef;
                if (colscale) t = t * *(const f32x4*)(colscale + c); gm[bj][n] = t; gsv[bj][n] = gq[4 + bj * 2 + n]; } }
#pragma unroll
        for (int ai = 0; ai < 2; ++ai)
#pragma unroll
          for (int mp = 0; mp < 4 / RB; ++mp) {
            if constexpr (GLU) {
                f32x4 gq8[4];
#pragma unroll
                for (int mm = 0; mm < 2; ++mm) { const bf16_t* pg = glu + (size_t)(row0 + ai * 128 + (2 * mp + mm) * 16) * D + col0; gld16<0>(gq8[mm * 2], pg); gld16<256>(gq8[mm * 2 + 1], pg); }
                gwait4(gq8);
#pragma unroll
                for (int mm = 0; mm < 2; ++mm)
#pragma unroll
                    for (int bj = 0; bj < 2; ++bj) { const u32x4 gw4 = __builtin_bit_cast(u32x4, gq8[mm * 2 + bj]); const int m = 2 * mp + mm;
#pragma unroll
                        for (int n = 0; n < 2; ++n) { const unsigned w0 = n ? gw4.z : gw4.x, w1 = n ? gw4.w : gw4.y; const f32x4 gg = {bf_lo(w0), bf_hi(w0), bf_lo(w1), bf_hi(w1)};
#pragma unroll
                            for (int j = 0; j < 4; ++j) acc[ai][bj][m][n][j] = gg[j] * fast_sigmoid(acc[ai][bj][m][n][j]); } }
            }
            f32x4 hq[2 * RB];
#pragma unroll
            for (int mm = 0; mm < RB; ++mm) { const _Float16* pb = baseh + (size_t)(row0 + ai * 128 + (RB * mp + mm) * 16) * D + col0; gld16<0>(hq[mm * 2], pb); gld16<256>(hq[mm * 2 + 1], pb); }
            if constexpr (RB == 2) gwait4(hq); else gwait8(hq);
#pragma unroll
            for (int mm = 0; mm < RB; ++mm) { const int m = RB * mp + mm; const int row = row0 + ai * 128 + m * 16; const size_t ro = (size_t)row * D;
                float sq = 0.f;
#pragma unroll
                for (int bj = 0; bj < 2; ++bj) { f32x4 o[2];
                    const h16x8 hb8 = __builtin_bit_cast(h16x8, hq[mm * 2 + bj]);
#pragma unroll
                    for (int n = 0; n < 2; ++n) { const f32x4 bs = {(float)hb8[4 * n], (float)hb8[4 * n + 1], (float)hb8[4 * n + 2], (float)hb8[4 * n + 3]};
                        o[n] = bs + gm[bj][n] * acc[ai][bj][m][n];
                        sq += (o[n][0] * o[n][0] + o[n][1] * o[n][1]) + (o[n][2] * o[n][2] + o[n][3] * o[n][3]); }
                    const int c = col0 + bj * 128;
                    if (out32) { *(f32x4*)(out32 + ro + c) = o[0]; *(f32x4*)(out32 + ro + c + 4) = o[1]; }
                    else { const u32x2 h0 = __builtin_bit_cast(u32x2, __builtin_convertvector(o[0], h16x4)), h1 = __builtin_bit_cast(u32x2, __builtin_convertvector(o[1], h16x4));
                        u32x4 w; w.x = h0.x; w.y = h0.y; w.z = h1.x; w.w = h1.y; *(u32x4*)(outh + ro + c) = w; }
                    if (gsb) *(u32x4*)(xs + ro + c) = pack8(o[0] * gsv[bj][0], o[1] * gsv[bj][1]); }
                if (gsb) { sq += __shfl_xor(sq, 16); sq += __shfl_xor(sq, 32); if (fq == 0) ssn[((size_t)u.pn * M + row) * 4 + wc] = sq; } }
            asm volatile("" ::: "memory"); }
    }
};

struct EpiQKV {         static constexpr bool HAS_SS = true; static constexpr int NAUX = 2;
    bf16_t *Qo; float* logf; const float *qg, *kg, *bfv; const float* ss; const float* bias; const LAS float* ssl;
    __device__ __forceinline__ const float* aux(int k, const Unit& u, int lane) const {
        return k == 0 ? bias + (size_t)(u.pm >> 5) * NFOX + u.pn * 256 + 4 * lane : (lane < 16 ? qg + 4 * lane : kg + 4 * (lane & 15)); }
    __device__ __forceinline__ void operator()(AccRef acc, const Unit& u, int wr, int wc, int fr, int fq) const {
        const int row0 = u.pm * 256 + wr * 64 + fr;
        float r8[2][4]; load_r8_lds(ssl, wr, fr, fq, r8);
        f32x4 bgv[8];
        { const LAS float* bl = ssl + 4096 + wc * 32 + 8 * fq; const LAS float* gl = ssl + 4096 + 256 + (u.pn < 4 ? 0 : 64) + 8 * fq;
          bgv[0] = *(const LAS f32x4*)bl; bgv[1] = *(const LAS f32x4*)(bl + 4); bgv[2] = *(const LAS f32x4*)(bl + 128); bgv[3] = *(const LAS f32x4*)(bl + 132);
          bgv[4] = *(const LAS f32x4*)gl; bgv[5] = *(const LAS f32x4*)(gl + 4); bgv[6] = *(const LAS f32x4*)(gl + 32); bgv[7] = *(const LAS f32x4*)(gl + 36); }
        if (u.pn < 12) {
            const int which = u.pn >> 2, head = 4 * (u.pn & 3) + wc;
            bf16_t* dst = Qo + (size_t)which * ((WS_R3 - WS_R2) / 2);
            const float gs = which == 0 ? QSCALE : 1.0f;
#pragma unroll
            for (int ai = 0; ai < 2; ++ai)
#pragma unroll
                for (int m = 0; m < 4; ++m) {
                    const int row = row0 + ai * 128 + m * 16; const float r = r8[ai][m];
                    f32x4 v[2][2];
#pragma unroll
                    for (int bj = 0; bj < 2; ++bj)
#pragma unroll
                        for (int n = 0; n < 2; ++n) v[bj][n] = acc[ai][bj][m][n] * r + bgv[bj * 2 + n];
                    float rinv = 1.0f;
                    if (which < 2) { float sq = 0.f;
#pragma unroll
                        for (int bj = 0; bj < 2; ++bj)
#pragma unroll
                            for (int n = 0; n < 2; ++n) { const f32x4 a = v[bj][n]; sq += (a[0] * a[0] + a[1] * a[1]) + (a[2] * a[2] + a[3] * a[3]); }
                        sq += __shfl_xor(sq, 16); sq += __shfl_xor(sq, 32);
                        rinv = rsqrtf(sq * (1.0f / 64.0f) + EPS) * gs; }
                    bf16_t* rp = dst + (size_t)row * D + head * 64 + 8 * fq;
#pragma unroll
                    for (int bj = 0; bj < 2; ++bj) {
                        f32x4 g0 = {1.f, 1.f, 1.f, 1.f}, g1 = g0;
                        if (which < 2) { g0 = bgv[4 + bj * 2]; g1 = bgv[5 + bj * 2]; }
                        *(u32x4*)(rp + 32 * bj) = pack8(v[bj][0] * rinv * g0, v[bj][1] * rinv * g1); }
                    asm volatile("" ::: "memory");
                }
        } else if (wc == 0 && fq < 2) {
#pragma unroll
            for (int ai = 0; ai < 2; ++ai)
#pragma unroll
                for (int m = 0; m < 4; ++m) { const int row = row0 + ai * 128 + m * 16; const float r = r8[ai][m];
#pragma unroll
                    for (int n = 0; n < 2; ++n) { const f32x4 bb = *(const f32x4*)(bfv + 8 * fq + 4 * n) + bgv[n]; f32x4 v = acc[ai][0][m][n] * r + bb;
#pragma unroll
                        for (int j = 0; j < 4; ++j) logf[((size_t)(row >> 13) * 16 + 8 * fq + 4 * n + j) * SEQ + (row & (SEQ - 1))] = log_sigmoid(v[j]); } }
        }
    }
};

struct EpiConvIn {      static constexpr bool HAS_SS = true; static constexpr int NAUX = 1;
    bf16_t *CZ, *BG; const float* ss; const float* bias; const LAS float* ssl;
    __device__ __forceinline__ const float* aux(int, const Unit& u, int lane) const { return bias + (size_t)(u.pm >> 5) * (3 * D) + u.pn * 256 + 4 * lane; }
    __device__ __forceinline__ void operator()(AccRef acc, const Unit& u, int wr, int wc, int fr, int fq) const {
        const int row0 = u.pm * 256 + wr * 64 + fr;
        const LAS float* bl = ssl + 4096 + wc * 32 + 8 * fq;
        const f32x4 bv[2][2] = {{*(const LAS f32x4*)bl, *(const LAS f32x4*)(bl + 4)}, {*(const LAS f32x4*)(bl + 128), *(const LAS f32x4*)(bl + 132)}};
        float r8[2][4]; load_r8_lds(ssl, wr, fr, fq, r8);
        if (u.pn < 8) {
#pragma unroll
            for (int ai = 0; ai < 2; ++ai)
#pragma unroll
                for (int m = 0; m < 4; ++m) { const int row = row0 + ai * 128 + m * 16; const float r = r8[ai][m];
                    *(u32x4*)(CZ + (size_t)row * D + u.pn * 128 + wc * 32 + 8 * fq) = pack8((acc[ai][0][m][0] * r + bv[0][0]) * (acc[ai][1][m][0] * r + bv[1][0]), (acc[ai][0][m][1] * r + bv[0][1]) * (acc[ai][1][m][1] * r + bv[1][1])); }
        } else {
#pragma unroll
            for (int ai = 0; ai < 2; ++ai)
#pragma unroll
                for (int m = 0; m < 4; ++m) { const int row = row0 + ai * 128 + m * 16; const float r = r8[ai][m];
#pragma unroll
                    for (int bj = 0; bj < 2; ++bj)
                        *(u32x4*)(BG + (size_t)row * D + (u.pn - 8) * 256 + bj * 128 + wc * 32 + 8 * fq) = pack8(acc[ai][bj][m][0] * r + bv[bj][0], acc[ai][bj][m][1] * r + bv[bj][1]); }
        }
    }
};

__device__ __forceinline__ int colmap(int type, int r) {
    const int pn = r >> 8, c = r & 255;
    if (type == 1) return (c >> 7) * DFF + pn * 128 + (c & 127);
    if (type == 2) return r < 3072 ? pn * 256 + ((c >> 5) & 3) * 64 + (c >> 7) * 32 + (c & 31) : r;
    if (type == 3) return pn < 8 ? 1024 + (c >> 7) * 1024 + pn * 128 + (c & 127) : (pn - 8) * 256 + c;
    return r;
}
__device__ __forceinline__ void transpose_item(const float* W, int ld, int K, bf16_t* WT, int type, int nvalid, LAS float* scr, int kb, int nb, int lane) {
    const int k0 = 64 * kb, n0 = 32 * nb; const int sc = colmap(type, n0) + (lane & 31); const bool ok = sc < nvalid;
    float wv[32];
#pragma unroll
    for (int i = 0; i < 32; ++i) { const int kk = 2 * i + (lane >> 5); wv[i] = ok ? W[(size_t)(k0 + kk) * ld + sc] : 0.f; }
#pragma unroll
    for (int i = 0; i < 32; ++i) { const int kk = 2 * i + (lane >> 5); scr[kk * 33 + (lane & 31)] = wv[i]; }
    asm volatile("s_waitcnt lgkmcnt(0)" ::: "memory");
    const int c = lane & 7;
#pragma unroll
    for (int j = 0; j < 4; ++j) { const int n = (lane >> 3) + 8 * j; const LAS float* s = scr + (8 * c) * 33 + n;
        u32x4 o; o.x = pk_bf16(s[0 * 33], s[1 * 33]); o.y = pk_bf16(s[2 * 33], s[3 * 33]); o.z = pk_bf16(s[4 * 33], s[5 * 33]); o.w = pk_bf16(s[6 * 33], s[7 * 33]);
        *(u32x4*)(WT + (size_t)(n0 + n) * K + k0 + 8 * c) = o; }
    asm volatile("s_waitcnt lgkmcnt(0)" ::: "memory");
}

__device__ __forceinline__ void prologue_phase(KP kp, LAS unsigned char* lds, int rep) {
    const int tid = opaque_tid(), lane = tid & 63, wid = tid >> 6, G = gridDim.x;
    unsigned char* ws = kp->ws;
    {
        LAS float* condS = (LAS float*)lds; LAS float* red = (LAS float*)(lds + 16384);
        const float* cin = kp->in[1];
        for (int i = tid; i < 4096; i += NTHREADS) condS[i] = silu_f(cin[i]);
        __syncthreads();
        float* mod = (float*)(ws + WS_MOD);
        const float* ada_w = kp->in[2]; const float* ada_b = kp->in[3];
        for (int it = blockIdx.x; it < 288; it += G) {
            const int l = it / 72, col0 = (it % 72) * 128, cq = tid & 31, kc = tid >> 5;
            f32x4 a0 = {0, 0, 0, 0}, a1 = a0, a2 = a0, a3 = a0;
            const float* wp = ada_w + ((size_t)l * D + kc * 64) * NMOD + col0 + cq * 4;
#pragma unroll 16
            for (int i = 0; i < 64; ++i) { const f32x4 w = *(const f32x4*)(wp + (size_t)i * NMOD); const int k = kc * 64 + i;
                a0 += w * condS[k]; a1 += w * condS[1024 + k]; a2 += w * condS[2048 + k]; a3 += w * condS[3072 + k]; }
            *(LAS f32x4*)(red + (kc * 4 + 0) * 128 + cq * 4) = a0; *(LAS f32x4*)(red + (kc * 4 + 1) * 128 + cq * 4) = a1;
            *(LAS f32x4*)(red + (kc * 4 + 2) * 128 + cq * 4) = a2; *(LAS f32x4*)(red + (kc * 4 + 3) * 128 + cq * 4) = a3;
            __syncthreads();
            { const int b = tid >> 7, col = tid & 127; float s = ada_b[l * NMOD + col0 + col];
#pragma unroll
              for (int k2 = 0; k2 < 16; ++k2) s += red[(k2 * 4 + b) * 128 + col];
              mod[(size_t)(l * 4 + b) * NMOD + col0 + col] = s; }
            __syncthreads();
        }
    }
    __syncthreads();
    {
        LAS float* scr = (LAS float*)(lds + wid * 8448);
        constexpr int I_FIN = 16 * 176, I_FOUT = 44 * 32, I_FOXIN = 16 * 104, I_SQ = 16 * 32, I_CONVIN = 16 * 96, I_POOL = 4 * 8;
        constexpr int NITEMS = 8 * I_FIN + 8 * I_FOUT + I_FOXIN + 3 * I_SQ + I_CONVIN + I_SQ * 0 + 4 * I_POOL;
        unsigned* steal = (unsigned*)(ws + WS_BAR) + 3584 + 64 * rep;
        for (;;) {
        unsigned base8 = 0u; if (lane == 0) base8 = atomicAdd(steal, 8u);
        base8 = (unsigned)__builtin_amdgcn_readfirstlane((int)base8);
        if (base8 >= (unsigned)NITEMS) break;
        for (int it = (int)base8; it < (int)base8 + 8 && it < NITEMS; ++it) {
            int r = it; const float* src; bf16_t* dst; int K, ld, nd, type = 0, nvalid;
            if (r < 8 * I_FIN) { const int j = r / I_FIN; r %= I_FIN; src = kp->in[5] + (size_t)j * D * 2 * DFF; dst = (bf16_t*)(ws + WS_WFFIN) + (size_t)j * 2 * DFF * D; K = D; ld = 2 * DFF; nd = 2 * DFF; type = 1; nvalid = ld; }
            else if ((r -= 8 * I_FIN) < 8 * I_FOUT) { const int j = r / I_FOUT; r %= I_FOUT; src = kp->in[6] + (size_t)j * DFF * D; dst = (bf16_t*)(ws + WS_WFFOUT) + (size_t)j * D * DFF; K = DFF; ld = D; nd = D; nvalid = ld; }
            else if ((r -= 8 * I_FOUT) < I_FOXIN) { src = kp->in[9]; dst = (bf16_t*)(ws + WS_WFOXIN); K = D; ld = 3 * D + 16; nd = NFOX; type = 2; nvalid = ld; }
            else if ((r -= I_FOXIN) < I_SQ) { src = kp->in[13]; dst = (bf16_t*)(ws + WS_WFOXO); K = D; ld = D; nd = D; nvalid = ld; }
            else if ((r -= I_SQ) < I_SQ) { src = kp->in[22]; dst = (bf16_t*)(ws + WS_WGLU); K = D; ld = D; nd = D; nvalid = ld; }
            else if ((r -= I_SQ) < I_CONVIN) { src = kp->in[23]; dst = (bf16_t*)(ws + WS_WCONVIN); K = D; ld = 3 * D; nd = 3 * D; type = 3; nvalid = ld; }
            else if ((r -= I_CONVIN) < I_SQ) { src = kp->in[25]; dst = (bf16_t*)(ws + WS_WCONVOUT); K = D; ld = D; nd = D; nvalid = ld; }
            else { r -= I_SQ; const int j = r / I_POOL; r %= I_POOL; src = kp->in[7] + (size_t)j * 256 * 256; dst = (bf16_t*)(ws + WS_WPOOL) + (size_t)j * 256 * 256; K = 256; ld = 256; nd = 256; nvalid = ld; }
            const int nblk = nd / 32;
            transpose_item(src, ld, K, dst, type, nvalid, scr, r / nblk, r % nblk, lane);
        }
        }
    }
}

__device__ __forceinline__ void load8(const bf16_t* p, float (&f)[8]) { const u32x4 w = *(const u32x4*)p; f[0] = bf_lo(w.x); f[1] = bf_hi(w.x); f[2] = bf_lo(w.y); f[3] = bf_hi(w.y); f[4] = bf_lo(w.z); f[5] = bf_hi(w.z); f[6] = bf_lo(w.w); f[7] = bf_hi(w.w); }
__device__ __forceinline__ void store8(bf16_t* p, const float (&f)[8]) { u32x4 w; w.x = pk_bf16(f[0], f[1]); w.y = pk_bf16(f[2], f[3]); w.z = pk_bf16(f[4], f[5]); w.w = pk_bf16(f[6], f[7]); *(u32x4*)p = w; }
__device__ __forceinline__ void norm0_phase(KP kp) {
    const int tid = opaque_tid(), lane = tid & 63, wid = tid >> 6;
    const int gw = blockIdx.x * NWAVES + wid, NGW = gridDim.x * NWAVES;
    unsigned char* ws = kp->ws;
    const float* mod = (const float*)(ws + WS_MOD); const float* gain = kp->in[4]; const float* x = kp->in[0];
    bf16_t* xs = (bf16_t*)(ws + WS_HB); float* ss = (float*)(ws + WS_SS); _Float16* xh = (_Float16*)(ws + WS_XH);
    for (int row0 = gw; row0 < M; row0 += 2 * NGW) {
        const int rowB = (row0 + NGW < M) ? row0 + NGW : row0;
        f32x4 v[2][4]; float sq[2] = {0.f, 0.f};
#pragma unroll
        for (int q = 0; q < 2; ++q) { const f32x4* xr = (const f32x4*)(x + (size_t)(q ? rowB : row0) * D) + lane;
#pragma unroll
            for (int j = 0; j < 4; ++j) v[q][j] = xr[64 * j]; }
#pragma unroll
        for (int q = 0; q < 2; ++q) {
#pragma unroll
            for (int j = 0; j < 4; ++j) sq[q] += (v[q][j][0] * v[q][j][0] + v[q][j][1] * v[q][j][1]) + (v[q][j][2] * v[q][j][2] + v[q][j][3] * v[q][j][3]);
            sq[q] = wave_sum(sq[q]); }
#pragma unroll
        for (int q = 0; q < 2; ++q) { const int row = q ? rowB : row0; if (q && rowB == row0) break;
            const float* scale = mod + (size_t)(row >> 13) * NMOD + D;
            if (lane < 16) ss[((size_t)(lane >> 2) * M + row) * 4 + (lane & 3)] = lane == 0 ? sq[q] : 0.f;
            u32x2* o8 = (u32x2*)(xs + (size_t)row * D) + lane; u32x2* h8 = (u32x2*)(xh + (size_t)row * D) + lane;
#pragma unroll
            for (int j = 0; j < 4; ++j) { const int c = 4 * (lane + 64 * j);
                const f32x4 o = v[q][j] * *(const f32x4*)(gain + c) * (*(const f32x4*)(scale + c) + 1.0f);
                u32x2 w; w.x = pk_bf16(o[0], o[1]); w.y = pk_bf16(o[2], o[3]); o8[64 * j] = w;
                h8[64 * j] = __builtin_bit_cast(u32x2, __builtin_convertvector(v[q][j], h16x4)); } }
    }
    { float* gs = (float*)(ws + WS_GS);
      for (int i = blockIdx.x * NTHREADS + tid; i < 12 * 4 * D; i += gridDim.x * NTHREADS) { const int c = i & (D - 1), b = (i >> 10) & 3, sidx = i >> 12, l = sidx / 3, sub = sidx % 3;
          gs[i] = gain[sidx * D + c] * (1.0f + mod[(size_t)(l * 4 + b) * NMOD + (sub * 3 + 1) * D + c]); } }
    { float* bv = (float*)(ws + WS_BIASV);
      constexpr int R_FFN = 2 * DFF, R_ALL = 8 * R_FFN + NFOX + 3 * D;
      for (int rr0 = gw; rr0 < R_ALL; rr0 += 2 * NGW) {
          const bf16_t* wrow[2]; const float* sh[2]; float* dst[2]; int nstr[2]; float w[2][16];
#pragma unroll
          for (int q = 0; q < 2; ++q) { const int rr = (q && rr0 + NGW < R_ALL) ? rr0 + NGW : rr0;
              if (rr < 8 * R_FFN) { const int j = rr / R_FFN, n = rr % R_FFN, l = j >> 1, sub = (j & 1) ? 2 : 0;
                  wrow[q] = (const bf16_t*)(ws + WS_WFFIN) + ((size_t)j * R_FFN + n) * D; sh[q] = mod + (size_t)l * 4 * NMOD + (sub * 3) * D; dst[q] = bv + (size_t)j * BV_FFN + n; nstr[q] = R_FFN; }
              else if (rr < 8 * R_FFN + NFOX) { const int n = rr - 8 * R_FFN; wrow[q] = (const bf16_t*)(ws + WS_WFOXIN) + (size_t)n * D; sh[q] = mod + (size_t)1 * 4 * NMOD + 3 * D; dst[q] = bv + BV_QKV_OFF + n; nstr[q] = NFOX; }
              else { const int n = rr - 8 * R_FFN - NFOX; wrow[q] = (const bf16_t*)(ws + WS_WCONVIN) + (size_t)n * D; sh[q] = mod + (size_t)3 * 4 * NMOD + 3 * D; dst[q] = bv + BV_CONV_OFF + n; nstr[q] = 3 * D; }
              float f[8]; load8(wrow[q] + 16 * lane, f);
#pragma unroll
              for (int j = 0; j < 8; ++j) w[q][j] = f[j];
              load8(wrow[q] + 16 * lane + 8, f);
#pragma unroll
              for (int j = 0; j < 8; ++j) w[q][8 + j] = f[j]; }
#pragma unroll
          for (int q = 0; q < 2; ++q) { if (q && rr0 + NGW >= R_ALL) break;
#pragma unroll
              for (int b = 0; b < 4; ++b) { const float* sp = sh[q] + (size_t)b * NMOD + 16 * lane; float a = 0.f;
#pragma unroll
                  for (int q4 = 0; q4 < 4; ++q4) { const f32x4 sv = *(const f32x4*)(sp + 4 * q4); a += (w[q][4 * q4] * sv[0] + w[q][4 * q4 + 1] * sv[1]) + (w[q][4 * q4 + 2] * sv[2] + w[q][4 * q4 + 3] * sv[3]); }
                  a = wave_sum(a); if (lane == 0) dst[q][(size_t)b * nstr[q]] = a; } }
      } }
}

__device__ __forceinline__ void load8n(const bf16_t* p, const float* ssp, int row, const float (&sh)[8], float (&f)[8]) { load8(p, f); const float r = rs_row(ssp, row);
#pragma unroll
    for (int j = 0; j < 8; ++j) f[j] = f[j] * r + sh[j]; }
__device__ __forceinline__ void pool_phase(const bf16_t* xs, const float* ss, const float* shiftl, bf16_t* pooled) {
    const int tid = opaque_tid();
    for (int wi = blockIdx.x; wi < 512; wi += gridDim.x) {
        const int rb = wi * 4 + (tid >> 7), o = tid & 127, w = 2 << (o >> 5);
        const int row0 = rb * 16, t0 = row0 & (SEQ - 1);
        const bf16_t* hp = xs + (size_t)row0 * D + o * 8;
        float sh[8]; { const float* shp = shiftl + (size_t)(row0 >> 13) * NMOD + o * 8;
#pragma unroll
            for (int j = 0; j < 8; ++j) sh[j] = shp[j]; }
        float sum[8], cur[8], old[8];
#pragma unroll
        for (int j = 0; j < 8; ++j) sum[j] = 0.f;
        for (int k = 1; k < w; ++k) if (t0 - k >= 0) { load8n(hp - (size_t)k * D, ss, row0 - k, sh, old);
#pragma unroll
            for (int j = 0; j < 8; ++j) sum[j] += old[j]; }
        for (int tt = 0; tt < 16; ++tt) {
            const int t = t0 + tt; load8n(hp + (size_t)tt * D, ss, row0 + tt, sh, cur);
            const float inv = 1.0f / (float)((t + 1) < w ? (t + 1) : w);
            float ov[8];
#pragma unroll
            for (int j = 0; j < 8; ++j) { sum[j] += cur[j]; ov[j] = sum[j] * inv - cur[j]; }
            store8(pooled + (size_t)(row0 + tt) * D + o * 8, ov);
            if (t - w + 1 >= 0) { load8n(hp + (size_t)(tt - w + 1) * D, ss, row0 + tt - w + 1, sh, old);
#pragma unroll
                for (int j = 0; j < 8; ++j) sum[j] -= old[j]; }
        }
    }
}

__device__ __forceinline__ void conv_phase(const bf16_t* cz, const bf16_t* bg, const float* cw, bf16_t* a2) {
    const int tid = opaque_tid(), o = tid & 127;
    float w0[8], w1[8], w2[8];
#pragma unroll
    for (int j = 0; j < 8; ++j) { w0[j] = cw[o * 8 + j]; w1[j] = cw[D + o * 8 + j]; w2[j] = cw[2 * D + o * 8 + j]; }
    for (int wi = blockIdx.x; wi < M / 16; wi += gridDim.x) {
        const int row0 = wi * 16 + (tid >> 7) * 4, t0 = row0 & (SEQ - 1);
        const size_t off = (size_t)row0 * D + o * 8;
        u32x4 xr[6], br[4];
#pragma unroll
        for (int k = 0; k < 6; ++k) xr[k] = (t0 + k - 2 >= 0) ? *(const u32x4*)(cz + off + (ptrdiff_t)(k - 2) * D) : (u32x4){0u, 0u, 0u, 0u};
#pragma unroll
        for (int k = 0; k < 4; ++k) br[k] = *(const u32x4*)(bg + off + (size_t)k * D);
        float x[6][8];
#pragma unroll
        for (int k = 0; k < 6; ++k) { x[k][0] = bf_lo(xr[k].x); x[k][1] = bf_hi(xr[k].x); x[k][2] = bf_lo(xr[k].y); x[k][3] = bf_hi(xr[k].y); x[k][4] = bf_lo(xr[k].z); x[k][5] = bf_hi(xr[k].z); x[k][6] = bf_lo(xr[k].w); x[k][7] = bf_hi(xr[k].w); }
#pragma unroll
        for (int k = 0; k < 4; ++k) { float b[8] = {bf_lo(br[k].x), bf_hi(br[k].x), bf_lo(br[k].y), bf_hi(br[k].y), bf_lo(br[k].z), bf_hi(br[k].z), bf_lo(br[k].w), bf_hi(br[k].w)}; float ov[8];
#pragma unroll
            for (int j = 0; j < 8; ++j) ov[j] = b[j] * (w0[j] * x[k][j] + w1[j] * x[k + 1][j] + w2[j] * x[k + 2][j]);
            store8(a2 + off + (size_t)k * D, ov); }
    }
}

__device__ __forceinline__ void cumsum_phase(const float* logf, float* biasK, LAS unsigned char* lds) {
    const int tid = opaque_tid(), lane = tid & 63, wid = tid >> 6;
    LAS float* wtot = (LAS float*)lds;
    for (int it = blockIdx.x; it < 64; it += gridDim.x) {
        const int b = it >> 4, h = it & 15;
        const size_t base = ((size_t)b * SEQ + tid * 16) * 16 + h;
        float v[16];
#pragma unroll
        for (int i = 0; i < 16; ++i) v[i] = logf[base + (size_t)i * 16];
#pragma unroll
        for (int i = 1; i < 16; ++i) v[i] += v[i - 1];
        float inc = v[15];
#pragma unroll
        for (int o = 1; o < 64; o <<= 1) { const float t = __shfl_up(inc, o); if (lane >= o) inc += t; }
        if (lane == 63) wtot[wid] = inc;
        __syncthreads();
        float off = inc - v[15];
        for (int w2 = 0; w2 < wid; ++w2) off += wtot[w2];
#pragma unroll
        for (int i = 0; i < 16; ++i) biasK[base + (size_t)i * 16] = -LOG2E * (v[i] + off);
        __syncthreads();
    }
}

__device__ __forceinline__ int crow(int r, int hi) { return (r & 3) + 8 * (r >> 2) + 4 * hi; }
__device__ __forceinline__ void att_tile(const LAS unsigned char* bb, const bf16x8 (&qr)[4], int t, int wq0, int qloc, int r32, int hi, float& mrun, float& lrun, f32x16 (&oT)[2]) {
    constexpr int ROWB = 144, KT = 64 * ROWB;
    const LAS float* bias = (const LAS float*)(bb + 2 * KT);
    f32x16 p0, p1;
#pragma unroll
    for (int g4 = 0; g4 < 4; ++g4) { const f32x4 b0 = *(const LAS f32x4*)(bias + 8 * g4 + 4 * hi), b1 = *(const LAS f32x4*)(bias + 32 + 8 * g4 + 4 * hi);
#pragma unroll
        for (int j = 0; j < 4; ++j) { p0[4 * g4 + j] = b0[j]; p1[4 * g4 + j] = b1[j]; } }
#pragma unroll
    for (int d0 = 0; d0 < 4; ++d0) {
        const bf16x8 k0 = *(const LAS bf16x8*)(bb + r32 * ROWB + d0 * 32 + hi * 16);
        const bf16x8 k1 = *(const LAS bf16x8*)(bb + (32 + r32) * ROWB + d0 * 32 + hi * 16);
        p0 = __builtin_amdgcn_mfma_f32_32x32x16_bf16(k0, qr[d0], p0, 0, 0, 0);
        p1 = __builtin_amdgcn_mfma_f32_32x32x16_bf16(k1, qr[d0], p1, 0, 0, 0);
    }
    if (64 * t + 63 > wq0) {
#pragma unroll
        for (int r = 0; r < 16; ++r) { const int kv = 64 * t + crow(r, hi); if (kv > qloc) p0[r] = -1e30f; if (kv + 32 > qloc) p1[r] = -1e30f; }
    }
    float mt = fmaxf(p0[0], p1[0]);
#pragma unroll
    for (int r = 1; r < 16; ++r) mt = fmaxf(mt, fmaxf(p0[r], p1[r]));
    mt = fmaxf(mt, __shfl_xor(mt, 32));
    const float mnew = fmaxf(mrun, mt);
    const float alpha = __builtin_amdgcn_exp2f(mrun - mnew);
    mrun = mnew;
    float ls = 0.f;
#pragma unroll
    for (int r = 0; r < 16; ++r) { p0[r] = __builtin_amdgcn_exp2f(p0[r] - mnew); p1[r] = __builtin_amdgcn_exp2f(p1[r] - mnew); ls += p0[r] + p1[r]; }
    lrun = lrun * alpha + ls;
#pragma unroll
    for (int r = 0; r < 16; ++r) { oT[0][r] *= alpha; oT[1][r] *= alpha; }
    bf16x8 pf[4];
    { u32x4 w;
      w.x = pk_bf16(p0[0], p0[1]); w.y = pk_bf16(p0[2], p0[3]); w.z = pk_bf16(p0[4], p0[5]); w.w = pk_bf16(p0[6], p0[7]); pf[0] = __builtin_bit_cast(bf16x8, w);
      w.x = pk_bf16(p0[8], p0[9]); w.y = pk_bf16(p0[10], p0[11]); w.z = pk_bf16(p0[12], p0[13]); w.w = pk_bf16(p0[14], p0[15]); pf[1] = __builtin_bit_cast(bf16x8, w);
      w.x = pk_bf16(p1[0], p1[1]); w.y = pk_bf16(p1[2], p1[3]); w.z = pk_bf16(p1[4], p1[5]); w.w = pk_bf16(p1[6], p1[7]); pf[2] = __builtin_bit_cast(bf16x8, w);
      w.x = pk_bf16(p1[8], p1[9]); w.y = pk_bf16(p1[10], p1[11]); w.z = pk_bf16(p1[12], p1[13]); w.w = pk_bf16(p1[14], p1[15]); pf[3] = __builtin_bit_cast(bf16x8, w); }
    const LAS unsigned char* vt = bb + KT;
#pragma unroll
    for (int db = 0; db < 2; ++db)
#pragma unroll
        for (int cc = 0; cc < 4; ++cc) {
            const bf16x8 vf = *(const LAS bf16x8*)(vt + (32 * db + r32) * ROWB + cc * 32 + hi * 16);
            oT[db] = __builtin_amdgcn_mfma_f32_32x32x16_bf16(vf, pf[cc], oT[db], 0, 0, 0);
        }
}
__device__ __forceinline__ void attn_phase(LAS unsigned char* lds, const bf16_t* Q, const bf16_t* Kg, const bf16_t* Vg, bf16_t* O, const float* logf, const float* qg, const float* kg) {
    const int tid = opaque_tid(), lane = tid & 63, wid = __builtin_amdgcn_readfirstlane(tid >> 6), r32 = lane & 31, hi = lane >> 5;
    const int G = gridDim.x, c = blockIdx.x;
    constexpr int ROWB = 144, KT = 64 * ROWB, BUF = 2 * KT + 256;
    const int kvr = tid >> 3, ch = tid & 7;
    const int slot = (kvr & ~15) | (kvr & 3) | ((kvr & 4) << 1) | ((kvr & 8) >> 1);
    float SB; { float a = fabsf(qg[lane]), b2 = fabsf(kg[lane]);
#pragma unroll
        for (int o = 1; o < 64; o <<= 1) { a = fmaxf(a, __shfl_xor(a, o)); b2 = fmaxf(b2, __shfl_xor(b2, o)); }
        SB = 64.0f * a * b2 * QSCALE * 1.02f; }
    for (int i = 0; i * G < 1024; ++i) {
        const int pidx = i * G + ((i & 1) ? (G - 1 - c) : c);
        if (pidx >= 1024) continue;
        const int qb = 15 - (pidx >> 6), bh = ((pidx & 63) + 9 * (pidx >> 8)) & 63, b = bh >> 4, h = bh & 15;
        const int q0 = qb * 512, NT = 8 * qb + 8;
        const size_t rowbase = (size_t)b * SEQ;
        bf16x8 qr[2][4];
#pragma unroll
        for (int sb = 0; sb < 2; ++sb)
#pragma unroll
            for (int d0 = 0; d0 < 4; ++d0) qr[sb][d0] = *(const bf16x8*)(Q + (rowbase + q0 + 256 * sb + wid * 32 + r32) * D + h * 64 + d0 * 16 + hi * 8);
        LAS float* wt = (LAS float*)(lds + 2 * BUF + 64); LAS float* bL = (LAS float*)(lds + 2 * BUF + 128);
        { const f32x4* lf = (const f32x4*)(logf + ((size_t)b * 16 + h) * SEQ + tid * 16);
          const f32x4 l0 = lf[0], l1 = lf[1], l2 = lf[2], l3 = lf[3];
          float v[16] = {l0[0], l0[1], l0[2], l0[3], l1[0], l1[1], l1[2], l1[3], l2[0], l2[1], l2[2], l2[3], l3[0], l3[1], l3[2], l3[3]};
#pragma unroll
          for (int e = 1; e < 16; ++e) v[e] += v[e - 1];
          float inc = v[15];
#pragma unroll
          for (int o = 1; o < 64; o <<= 1) { const float tt = __shfl_up(inc, o); if (lane >= o) inc += tt; }
          if (lane == 63) wt[wid] = inc;
          __syncthreads();
          float off = inc - v[15];
          for (int w2 = 0; w2 < wid; ++w2) off += wt[w2];
#pragma unroll
          for (int e = 0; e < 16; ++e) bL[tid * 16 + e] = -LOG2E * (v[e] + off);
          __syncthreads(); }
        const float ref = bL[q0 + 511];
        const bf16_t* kp = Kg + (rowbase + kvr) * D + h * 64 + ch * 8;
        const bf16_t* vp = Vg + (rowbase + kvr) * D + h * 64 + ch * 8;
        const LAS float* bp = bL + (tid & 63);
        u32x4 kreg = *(const u32x4*)(kp + (size_t)(NT - 1) * 64 * D), vreg = *(const u32x4*)(vp + (size_t)(NT - 1) * 64 * D); float breg = (tid < 64) ? bp[(NT - 1) * 64] - ref : 0.f;
#define ATT_WRITE(bufi) do { LAS unsigned char* bb_ = lds + (bufi) * BUF; \
            *(LAS u32x4*)(bb_ + kvr * ROWB + ch * 16) = kreg; \
            LAS bf16_t* vt_ = (LAS bf16_t*)(bb_ + KT) + (ch * 8) * (ROWB / 2) + slot; \
            vt_[0 * (ROWB / 2)] = (bf16_t)(vreg.x & 0xffff); vt_[1 * (ROWB / 2)] = (bf16_t)(vreg.x >> 16); \
            vt_[2 * (ROWB / 2)] = (bf16_t)(vreg.y & 0xffff); vt_[3 * (ROWB / 2)] = (bf16_t)(vreg.y >> 16); \
            vt_[4 * (ROWB / 2)] = (bf16_t)(vreg.z & 0xffff); vt_[5 * (ROWB / 2)] = (bf16_t)(vreg.z >> 16); \
            vt_[6 * (ROWB / 2)] = (bf16_t)(vreg.w & 0xffff); vt_[7 * (ROWB / 2)] = (bf16_t)(vreg.w >> 16); \
            if (tid < 64) ((LAS float*)(bb_ + 2 * KT))[tid] = breg; } while (0)
        ATT_WRITE((NT - 1) & 1);
        __syncthreads();
        float mrun[2] = {-1e30f, -1e30f}, lrun[2] = {0.f, 0.f};
        f32x16 oT[2][2];
#pragma unroll
        for (int r = 0; r < 16; ++r) { oT[0][0][r] = 0.f; oT[0][1][r] = 0.f; oT[1][0][r] = 0.f; oT[1][1][r] = 0.f; }
        for (int t = NT - 1; t >= 0; --t) {
            const int cur = t & 1;
            if (t > 0) { kreg = *(const u32x4*)(kp + (size_t)(t - 1) * 64 * D); vreg = *(const u32x4*)(vp + (size_t)(t - 1) * 64 * D); if (tid < 64) breg = bp[(t - 1) * 64] - ref; }
            const LAS unsigned char* bb = lds + cur * BUF;
            const float bmax = ((const LAS float*)(bb + 2 * KT))[63];
            int dead = 1;
#pragma unroll
            for (int sb = 0; sb < 2; ++sb) {
                const int wq0 = q0 + 256 * sb + wid * 32;
                const int dsb = __all((SB + bmax - mrun[sb]) < -150.0f);
                if (64 * t <= wq0 + 31) {
                    if (!dsb) att_tile(bb, qr[sb], t, wq0, wq0 + r32, r32, hi, mrun[sb], lrun[sb], oT[sb]);
                    dead &= dsb;
                } else dead = 0;
            }
            if (t > 0) ATT_WRITE(cur ^ 1);
            { LAS int* fl = (LAS int*)(lds + 2 * BUF) + cur * 8;
              if (lane == 0) fl[wid] = dead;
              __syncthreads();
              const LAS u32x4* fv = (const LAS u32x4*)fl; const u32x4 f0 = fv[0], f1 = fv[1];
              if ((f0.x & f0.y & f0.z & f0.w & f1.x & f1.y & f1.z & f1.w) != 0u) break; }
        }
#undef ATT_WRITE
#pragma unroll
        for (int sb = 0; sb < 2; ++sb) {
            const float ltot = lrun[sb] + __shfl_xor(lrun[sb], 32);
            const float rl = 1.0f / ltot;
            bf16_t* op = O + (rowbase + q0 + 256 * sb + wid * 32 + r32) * D + h * 64;
#pragma unroll
            for (int db = 0; db < 2; ++db)
#pragma unroll
                for (int g4 = 0; g4 < 4; ++g4) { u32x2 w; w.x = pk_bf16(oT[sb][db][4 * g4] * rl, oT[sb][db][4 * g4 + 1] * rl); w.y = pk_bf16(oT[sb][db][4 * g4 + 2] * rl, oT[sb][db][4 * g4 + 3] * rl);
                    *(u32x2*)(op + 32 * db + 8 * g4 + 4 * hi) = w; }
        }
    }
}

template <bool PASS_B>
__device__ __forceinline__ void s5_phase(KP kp, LAS unsigned char* lds, const bf16_t* hb, const float* ss, const float* shiftl, f32x2* Ebuf, bf16_t* gout) {
    const int tid = opaque_tid(), lane = tid & 63, wid = __builtin_amdgcn_readfirstlane(tid >> 6), l31 = lane & 31, hi = lane >> 5;
    constexpr int XROW = 272;
    LAS unsigned char* xS = lds + wid * (32 * XROW);
    const float *lam_re = kp->in[14], *lam_im = kp->in[15], *log_dt = kp->in[16], *b_re = kp->in[17], *b_im = kp->in[18], *c_re = kp->in[19], *c_im = kp->in[20], *d_skip = kp->in[21];
    const int gw = blockIdx.x * NWAVES + wid, NGW = gridDim.x * NWAVES;
    const int arow = 128 * ((l31 >> 2) & 1) + (l31 & 3) + 4 * (l31 >> 3);
    int gprev = -1;
    float lbr[2] = {0.f, 0.f}, lbi[2] = {0.f, 0.f}, p128r[2] = {0.f, 0.f}, p128i[2] = {0.f, 0.f}; bf16x8 bbf[4]; bf16x8 cf[8], df[2];
    for (int it = gw; it < 8192; it += NGW) {
        const int g = it & 63, b = (it >> 6) & 3, cp = it >> 8, ck = 2 * cp + hi;
        const size_t rowA = (size_t)b * SEQ + cp * 256;
        const float* shp = shiftl + (size_t)b * NMOD + 16 * g + 8 * hi; const f32x4 sh0 = *(const f32x4*)shp, sh1 = *(const f32x4*)(shp + 4);
        u32x4 uraw; f32x4 sp[4];
#define S5_ULOAD(blk_) do { const size_t row_ = rowA + arow + 16 * (blk_); uraw = *(const u32x4*)(hb + row_ * D + 16 * g + 8 * hi); \
            _Pragma("unroll") for (int pn_ = 0; pn_ < 4; ++pn_) sp[pn_] = *(const f32x4*)(ss + ((size_t)pn_ * M + row_) * 4); } while (0)
#define S5_UPACK(dst_) do { float t_ = 0.f; _Pragma("unroll") for (int pn_ = 0; pn_ < 4; ++pn_) t_ += (sp[pn_][0] + sp[pn_][1]) + (sp[pn_][2] + sp[pn_][3]); const float r_ = rs_of(t_); \
            dst_ = __builtin_bit_cast(bf16x8, pack8((f32x4){bf_lo(uraw.x), bf_hi(uraw.x), bf_lo(uraw.y), bf_hi(uraw.y)} * r_ + sh0, (f32x4){bf_lo(uraw.z), bf_hi(uraw.z), bf_lo(uraw.w), bf_hi(uraw.w)} * r_ + sh1)); } while (0)
        S5_ULOAD(0);
        if (g != gprev) {
        gprev = g;
        const float dt = __expf(log_dt[g]);
#pragma unroll
        for (int s2 = 0; s2 < 2; ++s2) {
            const int gn = g * 64 + l31 + 32 * s2;
            const float ar = lam_re[gn], ai = lam_im[gn];
            const float mag = __expf(ar * dt);
            float th = ai * dt; { const float kq = rintf(th * 0.15915494309189535f); th = fmaf(-kq, 6.28318548202514648f, th); th = fmaf(-kq, -1.7484555e-7f, th); }
            lbr[s2] = mag * cosf(th); lbi[s2] = mag * sinf(th);
            const float den = ar * ar + ai * ai, nr = lbr[s2] - 1.0f, ni = lbi[s2];
            const float kr = (nr * ar + ni * ai) / den, ki = (ni * ar - nr * ai) / den;
            const f32x4 br0 = *(const f32x4*)(b_re + (size_t)gn * 16 + 8 * hi), br1 = *(const f32x4*)(b_re + (size_t)gn * 16 + 8 * hi + 4);
            const f32x4 bi0 = *(const f32x4*)(b_im + (size_t)gn * 16 + 8 * hi), bi1 = *(const f32x4*)(b_im + (size_t)gn * 16 + 8 * hi + 4);
            bbf[s2] = __builtin_bit_cast(bf16x8, pack8(br0 * kr - bi0 * ki, br1 * kr - bi1 * ki));
            bbf[2 + s2] = __builtin_bit_cast(bf16x8, pack8(bi0 * kr + br0 * ki, bi1 * kr + br1 * ki));
        }
        if (PASS_B) {
#pragma unroll
            for (int s2 = 0; s2 < 2; ++s2) {
                float pr = lbr[s2], pi = lbi[s2];
#pragma unroll
                for (int q = 0; q < 7; ++q) { const float t = pr * pr - pi * pi; pi = 2.0f * pr * pi; pr = t; }
                p128r[s2] = pr; p128i[s2] = pi;
            }
            const int ci = l31 & 15; const bool cv = l31 < 16;
#pragma unroll
            for (int ks = 0; ks < 8; ++ks) {
                const float* cp2 = (ks < 4 ? c_re : c_im) + ((size_t)g * 16 + ci) * 64 + 16 * (ks & 3) + 8 * hi;
                f32x4 a = *(const f32x4*)cp2, bq = *(const f32x4*)(cp2 + 4);
                if (ks >= 4) { a = -a; bq = -bq; }
                if (!cv) { a = (f32x4){0.f, 0.f, 0.f, 0.f}; bq = a; }
                cf[ks] = __builtin_bit_cast(bf16x8, pack8(a, bq));
            }
            { const float dv = d_skip[16 * g + ci]; const unsigned dh = pk_bf16(dv, 0.f) & 0xffffu; const float dl = dv - bf_lo(dh); const unsigned dlo = pk_bf16(dl, 0.f) & 0xffffu;
              bf16x8 z = {0, 0, 0, 0, 0, 0, 0, 0}; df[0] = z; df[1] = z;
              const int j = ci - 8 * hi;
#pragma unroll
              for (int jj = 0; jj < 8; ++jj) if (cv && jj == j) { df[0][jj] = (short)dh; df[1][jj] = (short)dlo; } }
        }
        }
        float xr[2] = {0.f, 0.f}, xi[2] = {0.f, 0.f};
        if (PASS_B) {
            const f32x2* Ep0 = Ebuf + (((size_t)b * 64 + g) * 64) * 64 + l31;
            const int ckmax = 2 * cp + 1;
            for (int cb0 = 0; cb0 < ckmax; cb0 += 4) {
                f32x2 e0[4], e1[4];
#pragma unroll
                for (int k = 0; k < 4; ++k) { const int c2 = (cb0 + k < ckmax) ? cb0 + k : ckmax - 1; e0[k] = Ep0[(size_t)c2 * 64]; e1[k] = Ep0[(size_t)c2 * 64 + 32]; }
#pragma unroll
                for (int k = 0; k < 4; ++k) if (cb0 + k < ck) {
                    float t = p128r[0] * xr[0] - p128i[0] * xi[0] + e0[k].x; xi[0] = p128r[0] * xi[0] + p128i[0] * xr[0] + e0[k].y; xr[0] = t;
                    t = p128r[1] * xr[1] - p128i[1] * xi[1] + e1[k].x; xi[1] = p128r[1] * xi[1] + p128i[1] * xr[1] + e1[k].y; xr[1] = t; }
            }
        }
        bf16x8 uf; S5_UPACK(uf);
#pragma unroll 1
        for (int blk = 0; blk < 8; ++blk) {
            if (blk < 7) S5_ULOAD(blk + 1);
            f32x16 bu[4];
            { f32x16 z;
#pragma unroll
              for (int r = 0; r < 16; ++r) z[r] = 0.f;
#pragma unroll
              for (int cb = 0; cb < 4; ++cb) bu[cb] = __builtin_amdgcn_mfma_f32_32x32x16_bf16(uf, bbf[cb], z, 0, 0, 0); }
#pragma unroll
            for (int r = 0; r < 16; ++r) {
#pragma unroll
                for (int s2 = 0; s2 < 2; ++s2) { const float t2 = lbr[s2] * xr[s2] - lbi[s2] * xi[s2] + bu[s2][r]; xi[s2] = lbr[s2] * xi[s2] + lbi[s2] * xr[s2] + bu[2 + s2][r]; xr[s2] = t2;
                    bu[s2][r] = xr[s2]; bu[2 + s2][r] = xi[s2]; }
            }
            if (PASS_B) {
#pragma unroll
                for (int r = 0; r < 16; ++r) { LAS bf16_t* xp = (LAS bf16_t*)(xS + crow(r, hi) * XROW) + l31;
#pragma unroll
                    for (int cb = 0; cb < 4; ++cb) xp[32 * cb] = (bf16_t)(pk_bf16(bu[cb][r], 0.f) & 0xffffu); }
                f32x16 y;
#pragma unroll
                for (int r = 0; r < 16; ++r) y[r] = 0.f;
                y = __builtin_amdgcn_mfma_f32_32x32x16_bf16(uf, df[0], y, 0, 0, 0);
                y = __builtin_amdgcn_mfma_f32_32x32x16_bf16(uf, df[1], y, 0, 0, 0);
#pragma unroll
                for (int ks = 0; ks < 8; ++ks) { const bf16x8 af = *(const LAS bf16x8*)(xS + l31 * XROW + (16 * ks + 8 * hi) * 2); y = __builtin_amdgcn_mfma_f32_32x32x16_bf16(af, cf[ks], y, 0, 0, 0); }
                {
                    const int roff = (l31 < 16) ? 0 : 8;
#pragma unroll
                    for (int k = 0; k < 8; ++k) {
                        const auto sw = __builtin_amdgcn_permlane16_swap(__float_as_uint(y[k]), __float_as_uint(y[8 + k]), false, false);
                        gout[(rowA + 128 * hi + 16 * blk + roff + k) * D + 16 * g + (l31 & 15)] = (bf16_t)(pk_bf16(gelu_tanh(__uint_as_float(sw[0])), 0.f) & 0xffffu); }
                }
            }
            if (blk < 7) S5_UPACK(uf);
        }
#undef S5_ULOAD
#undef S5_UPACK
        if (!PASS_B) {
#pragma unroll
            for (int s2 = 0; s2 < 2; ++s2) Ebuf[((((size_t)b * 64 + g) * 64) + ck) * 64 + l31 + 32 * s2] = (f32x2){xr[s2], xi[s2]};
        }
    }
}

#define XB_TMO      128
#define XB_XCNT(j)  (256  + 64 * (j))
#define XB_XSUB(j)  (1280 + 64 * (j))
#define XB_XGEN(j)  (2304 + 64 * (j))
#define XB_TOP      3328
#define XB_TOPGEN   3392
#define XCD_BAR_WORDS 3456
#define XB_SPIN_CAP (1u << 18)

__device__ __forceinline__ unsigned xb_ld(unsigned* p)              { return __hip_atomic_load(p, __ATOMIC_RELAXED, __HIP_MEMORY_SCOPE_AGENT); }
__device__ __forceinline__ unsigned xb_add(unsigned* p, unsigned v) { return __hip_atomic_fetch_add(p, v, __ATOMIC_RELAXED, __HIP_MEMORY_SCOPE_AGENT); }
__device__ __forceinline__ unsigned xb_xcc_id() { return (unsigned)__builtin_amdgcn_s_getreg((3 << 11) | 20) & 0xFu; }
#define XB_SPIN(cond, bar) do { unsigned _sp = 0; while (cond) { __builtin_amdgcn_s_sleep(1); \
    if ((++_sp & 255u) == 0u) { if (xb_ld(&(bar)[XB_TMO])) break; if (_sp > XB_SPIN_CAP) { atomicAdd(&(bar)[XB_TMO], 1u); break; } } } } while (0)

struct XcdBarrier {
    unsigned* bar; unsigned x;
    volatile LAS unsigned* st;
};

__device__ __forceinline__ XcdBarrier xcd_barrier_post(unsigned* bar, volatile LAS unsigned* st) {
    XcdBarrier b; b.bar = bar; b.x = xb_xcc_id(); b.st = st;
    if (threadIdx.x == 0) (void)xb_add(&bar[XB_XCNT(b.x)], 1u);
    return b;
}
__device__ __forceinline__ void xcd_barrier_complete(unsigned* bar, unsigned x, unsigned& nloc, unsigned& nx) {
    const unsigned G = gridDim.x * gridDim.y * gridDim.z;
    unsigned sum, cnt, mine, sp = 0u;
    for (;;) {
        sum = 0u; cnt = 0u; mine = 0u;
#pragma unroll
        for (unsigned j = 0; j < 16; ++j) { const unsigned c = xb_ld(&bar[XB_XCNT(j)]); sum += c; cnt += (c > 0u) ? 1u : 0u; mine = (j == x) ? c : mine; }
        if (sum == G) break;
        __builtin_amdgcn_s_sleep(1);
        if ((++sp & 255u) == 0u) { if (xb_ld(&bar[XB_TMO])) break; if (sp > XB_SPIN_CAP) { atomicAdd(&bar[XB_TMO], 1u); break; } }
    }
    nloc = mine > 0u ? mine : 1u; nx = cnt > 0u ? cnt : 1u;
}

__device__ __forceinline__ void xcd_barrier(const XcdBarrier& b) {
    asm volatile("s_waitcnt vmcnt(0)" ::: "memory");
    __syncthreads();
    if (threadIdx.x == 0) {
        unsigned* bar = b.bar;
        __builtin_amdgcn_s_waitcnt(0);
        unsigned nloc = b.st[0], nx = b.st[1];
        if (nloc == 0u) { xcd_barrier_complete(bar, b.x, nloc, nx); b.st[0] = nloc; b.st[1] = nx; }
        const unsigned old = xb_add(&bar[XB_XSUB(b.x)], 1u);
        const unsigned gen = old / nloc;
        if (old + 1u == (gen + 1u) * nloc) {
            __builtin_amdgcn_fence(__ATOMIC_RELEASE, "agent");
            asm volatile("s_waitcnt vmcnt(0)" ::: "memory");
            const unsigned og = xb_add(&bar[XB_TOP], 1u);
            const unsigned tg = og / nx;
            if (og + 1u == (tg + 1u) * nx) xb_add(&bar[XB_TOPGEN], 1u);
            else XB_SPIN(xb_ld(&bar[XB_TOPGEN]) == tg, bar);
            __builtin_amdgcn_fence(__ATOMIC_ACQUIRE, "agent");
            xb_add(&bar[XB_XGEN(b.x)], 1u);
            asm volatile("s_waitcnt vmcnt(0)" ::: "memory");
        } else {
            XB_SPIN(xb_ld(&bar[XB_XGEN(b.x)]) == gen, bar);
            __builtin_amdgcn_fence(__ATOMIC_ACQUIRE, "agent");
            asm volatile("s_waitcnt vmcnt(0)" ::: "memory");
        }
    }
    __syncthreads();
}


enum Kind { K_PROLOGUE, K_NORM, K_FFNIN, K_FFNOUT, K_POOL_EW, K_POOL_GEMM, K_QKV, K_CUMSUM, K_ATTN, K_WO, K_S5A, K_S5B, K_GLU, K_CONVIN, K_CONV_EW, K_CONVOUT };
constexpr int NPHASES = 2 + 6 + 7 + 7 + 7;
__host__ __device__ inline void decode_phase(int ph, int& layer, int& kind, int& sub) {
    layer = 0; sub = 0; kind = K_PROLOGUE; if (ph == 0) return;
    if (ph == 1) { kind = K_NORM; return; }
    int r = ph - 2;
    for (int l = 0; l < 4; ++l) {
        const int nm = (l == 0) ? 2 : 3, n = 4 + nm;
        if (r < n) { layer = l;
            if (r < 2) { sub = 0; kind = r == 0 ? K_FFNIN : K_FFNOUT; }
            else if (r < 2 + nm) { sub = 1; const int q = r - 2;
                kind = l == 0 ? (q == 0 ? K_POOL_EW : K_POOL_GEMM) : l == 1 ? (q == 0 ? K_QKV : q == 1 ? K_ATTN : K_WO)
                     : l == 2 ? (q == 0 ? K_S5A : q == 1 ? K_S5B : K_GLU) : (q == 0 ? K_CONVIN : q == 1 ? K_CONV_EW : K_CONVOUT); }
            else { sub = 2; const int q = r - 2 - nm; kind = q == 0 ? K_FFNIN : K_FFNOUT; }
            return; }
        r -= n;
    }
}

__global__ void __launch_bounds__(NTHREADS, 2) mega_fwd(Params p_arg) {
    extern __shared__ __attribute__((aligned(16))) unsigned char lds_raw[];
    LAS unsigned char* lds = (LAS unsigned char*)lds_raw;
    cg::grid_group grid = cg::this_grid();
    const KP kp0 = (KP)__builtin_amdgcn_kernarg_segment_ptr();
    const int lo = kp0->lo, hi = kp0->hi;
    volatile LAS unsigned* bst = (volatile LAS unsigned*)(lds + LDS_MAIN + LDS_SSL);
    if (threadIdx.x < 4) bst[threadIdx.x] = 0u;
    __syncthreads();
    const XcdBarrier xbar = xcd_barrier_post((unsigned*)(kp0->ws + WS_BAR), bst);
#define WSP(T, off) ((T*)(ws + (off)))
    for (int ph = lo; ph < hi; ++ph) {
        KP kp = kp0; asm volatile("" : "+s"(kp));
        int layer, kind, sub; decode_phase(ph, layer, kind, sub);
        const int reps = 1 + ((REPMASK >> kind) & 1);
        for (int rep = 0; rep < reps; ++rep) {
        if (rep) xcd_barrier(xbar);
        unsigned char* ws = kp->ws;
        const int sidx = layer * 3 + sub;
        switch (kind) {
        case K_PROLOGUE: prologue_phase(kp, lds, rep); break;
        case K_NORM: norm0_phase(kp); break;
        case K_FFNIN: {
            const int ffi = layer * 2 + (sub == 2 ? 1 : 0);
            const pg8::Gemm g{WSP(const bf16_t, WS_HB), WSP(const bf16_t, WS_WFFIN) + (size_t)ffi * 2 * DFF * D, M, 2 * DFF, D, D, 0};
            pg8::StaticOrder S; S.init(M, 2 * DFF, gridDim.x, blockIdx.x);
            const EpiSwiglu E{WSP(bf16_t, WS_HH), WSP(const float, WS_SS) + (size_t)(sidx & 1) * 16 * M, WSP(const float, WS_BIASV) + (size_t)ffi * BV_FFN, (const LAS float*)(lds + LDS_MAIN)};
            pg8::gemm_phase<EpiSwiglu, true>(lds, g, S, E);
        } break;
        case K_QKV: {
            const pg8::Gemm g{WSP(const bf16_t, WS_HB), WSP(const bf16_t, WS_WFOXIN), M, NFOX, D, D, 0};
            pg8::StaticOrder S; S.init(M, NFOX, gridDim.x, blockIdx.x);
            const EpiQKV E{WSP(bf16_t, WS_R2), WSP(float, WS_LOGF), kp->in[11], kp->in[12], kp->in[10], WSP(const float, WS_SS) + (size_t)(sidx & 1) * 16 * M, WSP(const float, WS_BIASV) + BV_QKV_OFF, (const LAS float*)(lds + LDS_MAIN)};
            pg8::gemm_phase<EpiQKV, true>(lds, g, S, E);
        } break;
        case K_CONVIN: {
            const pg8::Gemm g{WSP(const bf16_t, WS_HB), WSP(const bf16_t, WS_WCONVIN), M, 3 * D, D, D, 0};
            pg8::StaticOrder S; S.init(M, 3 * D, gridDim.x, blockIdx.x);
            const EpiConvIn E{WSP(bf16_t, WS_R2), WSP(bf16_t, WS_R3), WSP(const float, WS_SS) + (size_t)(sidx & 1) * 16 * M, WSP(const float, WS_BIASV) + BV_CONV_OFF, (const LAS float*)(lds + LDS_MAIN)};
            pg8::gemm_phase<EpiConvIn, true>(lds, g, S, E);
        } break;
        case K_FFNOUT: case K_POOL_GEMM: case K_WO: case K_GLU: case K_CONVOUT: {
            const int ffi = layer * 2 + (sub == 2 ? 1 : 0);
            size_t aoff = WS_R2, boff; int K = D, lda = D, apn = 0; float coef = 1.0f; const float* colscale = nullptr; const bf16_t* glu = nullptr;
            if (kind == K_FFNOUT) { aoff = WS_HH; boff = WS_WFFOUT + (size_t)ffi * D * DFF * 2; K = DFF; lda = DFF; coef = 0.5f; }
            else if (kind == K_POOL_GEMM) { boff = WS_WPOOL; K = 256; apn = 256; colscale = kp->in[8]; }
            else if (kind == K_WO) { aoff = WS_HH; boff = WS_WFOXO; }
            else if (kind == K_GLU) { boff = WS_WGLU; glu = WSP(const bf16_t, WS_R2); }
            else { aoff = WS_R4; boff = WS_WCONVOUT; }
            const pg8::Gemm g{WSP(const bf16_t, aoff), WSP(const bf16_t, boff), M, D, K, lda, apn};
            pg8::StaticOrder S; S.init(M, D, gridDim.x, blockIdx.x);
            if (kind == K_GLU) {
                const EpiRes<true> E{WSP(const _Float16, WS_XH), nullptr, WSP(_Float16, WS_XH), WSP(const float, WS_MOD) + (size_t)layer * 4 * NMOD + (sub * 3 + 2) * D, colscale, glu,
                                     WSP(const float, WS_GS) + (size_t)(sidx + 1) * 4 * D, WSP(float, WS_SS) + (size_t)((sidx + 1) & 1) * 16 * M, WSP(bf16_t, WS_HB), (rep + 1 < reps) ? 0.0f : coef, 0};
                pg8::gemm_phase<EpiRes<true>, true>(lds, g, S, E);
            } else {
                const EpiRes<false> E{WSP(const _Float16, WS_XH), sidx == 11 ? kp->out : nullptr, WSP(_Float16, WS_XH), WSP(const float, WS_MOD) + (size_t)layer * 4 * NMOD + (sub * 3 + 2) * D, colscale, glu,
                                      sidx < 11 ? WSP(const float, WS_GS) + (size_t)(sidx + 1) * 4 * D : nullptr, WSP(float, WS_SS) + (size_t)((sidx + 1) & 1) * 16 * M, WSP(bf16_t, WS_HB), (rep + 1 < reps) ? 0.0f : coef, 0};
                pg8::gemm_phase<EpiRes<false>, true>(lds, g, S, E);
            }
        } break;
        case K_POOL_EW: pool_phase(WSP(const bf16_t, WS_HB), WSP(const float, WS_SS) + (size_t)(sidx & 1) * 16 * M, WSP(const float, WS_MOD) + (size_t)layer * 4 * NMOD + 3 * D, WSP(bf16_t, WS_R2)); break;
        case K_CUMSUM: cumsum_phase(WSP(const float, WS_LOGF), WSP(float, WS_BIASK), lds); break;
        case K_ATTN: attn_phase(lds, WSP(const bf16_t, WS_R2), WSP(const bf16_t, WS_R3), WSP(const bf16_t, WS_R4), WSP(bf16_t, WS_HH), WSP(const float, WS_LOGF), kp->in[11], kp->in[12]); break;
        case K_S5A: s5_phase<false>(kp, lds, WSP(const bf16_t, WS_HB), WSP(const float, WS_SS) + (size_t)(sidx & 1) * 16 * M, WSP(const float, WS_MOD) + (size_t)layer * 4 * NMOD + 3 * D, WSP(f32x2, WS_E), WSP(bf16_t, WS_R2)); break;
        case K_S5B: s5_phase<true>(kp, lds, WSP(const bf16_t, WS_HB), WSP(const float, WS_SS) + (size_t)(sidx & 1) * 16 * M, WSP(const float, WS_MOD) + (size_t)layer * 4 * NMOD + 3 * D, WSP(f32x2, WS_E), WSP(bf16_t, WS_R2)); break;
        case K_CONV_EW: conv_phase(WSP(const bf16_t, WS_R2), WSP(const bf16_t, WS_R3), kp->in[24], WSP(bf16_t, WS_R4)); break;
        default: break;
        }
        }
        if (ph + 1 < hi) { if (ph == lo) grid.sync(); else xcd_barrier(xbar); }
    }
#undef WSP
}

extern "C" void kernel_launch(void* const* d_in, const int* in_sizes, int n_in, void* d_out, int out_size, void* d_ws, size_t ws_size, hipStream_t stream) {
    static int grid = 0;
    if (grid == 0) {
        if (n_in != 26 || out_size != M * D || ws_size < WS_END) { fprintf(stderr, "kernel_launch: unexpected shapes (n_in %d out %d ws %zu)\n", n_in, out_size, ws_size); grid = -1; return; }
        int dev = 0, cus = 0, per_cu = 0;
        (void)hipGetDevice(&dev); (void)hipDeviceGetAttribute(&cus, hipDeviceAttributeMultiprocessorCount, dev);
        if (hipFuncSetAttribute((const void*)mega_fwd, hipFuncAttributeMaxDynamicSharedMemorySize, LDS_BYTES) != hipSuccess) { fprintf(stderr, "kernel_launch: hipFuncSetAttribute failed\n"); grid = -1; return; }
        if (hipOccupancyMaxActiveBlocksPerMultiprocessor(&per_cu, (const void*)mega_fwd, NTHREADS, LDS_BYTES) != hipSuccess || per_cu < 1) { fprintf(stderr, "kernel_launch: occupancy query gave %d\n", per_cu); per_cu = 1; }
        (void)hipGetLastError();
        grid = cus * per_cu;
        fprintf(stderr, "kernel_launch: grid %d (cus %d x %d)\n", grid, cus, per_cu);
    }
    if (grid < 0) return;
    (void)hipMemsetAsync((unsigned char*)d_ws + WS_BAR, 0, BAR_BYTES, stream);
    Params p{};
    for (int i = 0; i < 26; ++i) p.in[i] = (const float*)d_in[i];
    p.out = (float*)d_out; p.ws = (unsigned char*)d_ws;
#if MK_ONE_LAUNCH
    p.lo = 0; p.hi = NPHASES;
    void* args[] = {&p};
    hipError_t e = hipLaunchCooperativeKernel((const void*)mega_fwd, dim3(grid), dim3(NTHREADS), args, LDS_BYTES, stream);
    if (e != hipSuccess) fprintf(stderr, "cooperative launch failed: %s (grid %d)\n", hipGetErrorString(e), grid);
#else
    for (int ph = 0; ph < NPHASES; ++ph) {
        p.lo = ph; p.hi = ph + 1;
        hipLaunchKernelGGL(mega_fwd, dim3(grid), dim3(NTHREADS), LDS_BYTES, stream, p);
    }
#endif
}
```
